# Optimizing an MI355X kernel written in HIP

```python
import math
import jax, jax.numpy as jnp
from jax import lax
import numpy as np

D_MODEL = 1024
BATCH = 1
SEQ = 16384
DEPTH = 4
DEC_BATCH = 8
DEC_SEQ = 4096
PAST_LEN = 128

GRID_W = 64
HEAD_DIM = 64
ATTN_HEADS = 8
ATTN_KV_HEADS = 2
RET_HEADS = 4
RET_KEY_DIM = HEAD_DIM
RET_VALUE_DIM = 2 * RET_KEY_DIM
RET_CHUNK = 128
Q_BLOCK = 128
D_FF = 2816
ROPE_THETA = 10000.0
ROPE_AXIS_PAIRS = HEAD_DIM // 4
NORM_EPS = 1e-6
ATTN_Q_W = ATTN_HEADS * HEAD_DIM
ATTN_KV_W = ATTN_KV_HEADS * HEAD_DIM
RET_QK_W = RET_HEADS * RET_KEY_DIM
RET_V_W = RET_HEADS * RET_VALUE_DIM
IN_PROJ_W = ATTN_Q_W + 2 * ATTN_KV_W + 2 * RET_QK_W + 2 * RET_V_W

kernel_name = 'hybrid_gqa_retention_macaron_encoder'


def rmsnorm(x, g):
    x32 = x.astype(jnp.float32)
    y = x32 * lax.rsqrt(jnp.mean(x32 * x32, axis=-1, keepdims=True) + NORM_EPS)
    return (y * g.astype(jnp.float32)).astype(x.dtype)


def swiglu_ffn(x, g, w13, w2):
    h = rmsnorm(x, g) @ w13
    a, b = jnp.split(h, 2, axis=-1)
    return (jax.nn.silu(a) * b) @ w2


def axial_rope_tables(T):
    rows = T // GRID_W
    row = jnp.repeat(jnp.arange(rows, dtype=jnp.float32), GRID_W)
    col = jnp.tile(jnp.arange(GRID_W, dtype=jnp.float32), rows)
    freqs = ROPE_THETA ** (-jnp.arange(ROPE_AXIS_PAIRS, dtype=jnp.float32) / ROPE_AXIS_PAIRS)
    ang = jnp.concatenate([row[:, None] * freqs, col[:, None] * freqs], axis=-1)
    return jnp.cos(ang), jnp.sin(ang)


def apply_rope(x, cos, sin):
    x32 = x.astype(jnp.float32)
    x1, x2 = jnp.split(x32, 2, axis=-1)
    c = cos[None, :, None, :]
    s = sin[None, :, None, :]
    return jnp.concatenate([x1 * c - x2 * s, x1 * s + x2 * c], axis=-1).astype(x.dtype)


def gqa_block_attention(q, k, v):
    B, T, H, hd = q.shape
    G = H // ATTN_KV_HEADS
    nb = T // Q_BLOCK
    qb = q.reshape(B, nb, Q_BLOCK, ATTN_KV_HEADS, G, hd).transpose(1, 0, 3, 4, 2, 5)
    scale = hd ** -0.5

    def block(qi):
        s = jnp.einsum('bkgqd,btkd->bkgqt', qi, k).astype(jnp.float32) * scale
        p = jax.nn.softmax(s, axis=-1).astype(v.dtype)
        return jnp.einsum('bkgqt,btkd->bkgqd', p, v)

    o = lax.map(block, qb)
    return o.transpose(1, 0, 4, 2, 3, 5).reshape(B, T, H * hd)


def retention_one_direction(q, k, v, decay_logit, include_diag):
    B, T, H, dk = q.shape
    dv = v.shape[-1]
    C = RET_CHUNK
    N = T // C
    log_gamma = jnp.log1p(-jnp.exp(decay_logit.astype(jnp.float32)))
    idx = jnp.arange(C, dtype=jnp.float32)
    diff = idx[:, None] - idx[None, :]
    mask = diff >= 0 if include_diag else diff > 0
    dmat = jnp.where(mask[None], jnp.exp(jnp.where(mask, diff, 0.0)[None] * log_gamma[:, None, None]), 0.0)
    q_decay = jnp.exp((idx[None, :] + 1.0) * log_gamma[:, None])[..., None]
    k_decay = jnp.exp((C - 1.0 - idx[None, :]) * log_gamma[:, None])[..., None]
    chunk_decay = jnp.exp(C * log_gamma)[:, None, None]

    def to_chunks(a):
        return a.reshape(B, N, C, H, a.shape[-1]).transpose(1, 0, 3, 2, 4)

    def step(S, inp):
        qi, ki, vi = inp
        inner = jnp.einsum('bhqd,bhkd->bhqk', qi, ki) * dmat
        o = jnp.einsum('bhqk,bhkv->bhqv', inner, vi) + jnp.einsum('bhqd,bhdv->bhqv', qi * q_decay, S)
        S = S * chunk_decay + jnp.einsum('bhkd,bhkv->bhdv', ki * k_decay, vi)
        return S, o

    S0 = jnp.zeros((B, H, dk, dv), jnp.float32)
    _, o = lax.scan(step, S0, (to_chunks(q), to_chunks(k), to_chunks(v)))
    return o.transpose(1, 0, 3, 2, 4).reshape(B, T, H, dv)


def bidirectional_retention(q, k, v, decay_fwd, decay_bwd):
    q32, k32, v32 = q.astype(jnp.float32), k.astype(jnp.float32), v.astype(jnp.float32)
    fwd = retention_one_direction(q32, k32, v32, decay_fwd, True)
    bwd = jnp.flip(retention_one_direction(jnp.flip(q32, 1), jnp.flip(k32, 1), jnp.flip(v32, 1), decay_bwd, False), 1)
    return fwd + bwd


def head_group_norm(y, g):
    mu = jnp.mean(y, axis=-1, keepdims=True)
    var = jnp.mean(jnp.square(y - mu), axis=-1, keepdims=True)
    yn = (y - mu) * lax.rsqrt(var + NORM_EPS)
    B, T, H, dv = y.shape
    return yn.reshape(B, T, H * dv) * g.astype(jnp.float32)


def token_mixers(h, cos, sin, w_in, q_norm, k_norm, dec_f, dec_b, ret_norm,
                 w_branch_attn, w_branch_ret, w_gate, b_gate, w_out):
    B, T, _ = h.shape
    proj = h @ w_in
    offs = [ATTN_Q_W, ATTN_Q_W + ATTN_KV_W, ATTN_Q_W + 2 * ATTN_KV_W,
            ATTN_Q_W + 2 * ATTN_KV_W + RET_QK_W, ATTN_Q_W + 2 * ATTN_KV_W + 2 * RET_QK_W,
            ATTN_Q_W + 2 * ATTN_KV_W + 2 * RET_QK_W + RET_V_W]
    aq, ak, av, rq, rk, rv, rg = jnp.split(proj, offs, axis=-1)
    aq = apply_rope(rmsnorm(aq.reshape(B, T, ATTN_HEADS, HEAD_DIM), q_norm), cos, sin)
    ak = apply_rope(rmsnorm(ak.reshape(B, T, ATTN_KV_HEADS, HEAD_DIM), k_norm), cos, sin)
    av = av.reshape(B, T, ATTN_KV_HEADS, HEAD_DIM)
    ya = gqa_block_attention(aq, ak, av) @ w_branch_attn
    rq = apply_rope(rq.reshape(B, T, RET_HEADS, RET_KEY_DIM), cos, sin)
    rk = apply_rope(rk.reshape(B, T, RET_HEADS, RET_KEY_DIM), cos, sin) * (RET_KEY_DIM ** -0.5)
    rv = rv.reshape(B, T, RET_HEADS, RET_VALUE_DIM)
    yr = head_group_norm(bidirectional_retention(rq, rk, rv, dec_f, dec_b), ret_norm).astype(h.dtype)
    yr = (jax.nn.silu(rg) * yr) @ w_branch_ret
    gates = jax.nn.sigmoid((h @ w_gate + b_gate).astype(jnp.float32)).astype(h.dtype)
    g_a, g_r = jnp.split(gates, 2, axis=-1)
    return (g_a * ya + g_r * yr) @ w_out


def trunk(x, ffn1_norm, ffn1_w13, ffn1_w2, mix_norm, w_in, q_norm, k_norm,
          ret_decay_fwd, ret_decay_bwd, ret_norm, w_branch_attn, w_branch_ret,
          w_gate, b_gate, w_out, ffn2_norm, ffn2_w13, ffn2_w2, final_norm):
    T = x.shape[1]
    cos, sin = axial_rope_tables(T)
    for l in range(DEPTH):
        x = x + 0.5 * swiglu_ffn(x, ffn1_norm[l], ffn1_w13[l], ffn1_w2[l])
        h = rmsnorm(x, mix_norm[l])
        x = x + token_mixers(h, cos, sin, w_in[l], q_norm[l], k_norm[l], ret_decay_fwd[l],
                             ret_decay_bwd[l], ret_norm[l], w_branch_attn[l], w_branch_ret[l],
                             w_gate[l], b_gate[l], w_out[l])
        x = x + 0.5 * swiglu_ffn(x, ffn2_norm[l], ffn2_w13[l], ffn2_w2[l])
    return rmsnorm(x, final_norm)


def setup_inputs(seed: int = 0) -> dict:
    key = jax.random.key(seed)
    ks = jax.random.split(key, 24)

    def nrm(k, shape, scale):
        return jax.random.normal(k, shape, jnp.float32) * scale

    base_decay = -(5.0 + jnp.arange(RET_HEADS, dtype=jnp.float32)) * math.log(2.0)
    return {
        'x_prompt': nrm(ks[0], (BATCH, SEQ, D_MODEL), 1.0),
        'x_sample': nrm(ks[1], (DEC_BATCH, DEC_SEQ, D_MODEL), 1.0),
        'ffn1_norm': 1.0 + nrm(ks[2], (DEPTH, D_MODEL), 0.02),
        'ffn1_w13': nrm(ks[3], (DEPTH, D_MODEL, 2 * D_FF), D_MODEL ** -0.5),
        'ffn1_w2': nrm(ks[4], (DEPTH, D_FF, D_MODEL), D_FF ** -0.5),
        'mix_norm': 1.0 + nrm(ks[5], (DEPTH, D_MODEL), 0.02),
        'w_in': nrm(ks[6], (DEPTH, D_MODEL, IN_PROJ_W), D_MODEL ** -0.5),
        'q_norm': 1.0 + nrm(ks[7], (DEPTH, HEAD_DIM), 0.02),
        'k_norm': 1.0 + nrm(ks[8], (DEPTH, HEAD_DIM), 0.02),
        'ret_decay_fwd': base_decay + nrm(ks[9], (DEPTH, RET_HEADS), 0.05),
        'ret_decay_bwd': base_decay + nrm(ks[10], (DEPTH, RET_HEADS), 0.05),
        'ret_norm': 1.0 + nrm(ks[11], (DEPTH, RET_V_W), 0.02),
        'w_branch_attn': nrm(ks[12], (DEPTH, ATTN_Q_W, D_MODEL), ATTN_Q_W ** -0.5),
        'w_branch_ret': nrm(ks[13], (DEPTH, RET_V_W, D_MODEL), RET_V_W ** -0.5),
        'w_gate': nrm(ks[14], (DEPTH, D_MODEL, 2 * D_MODEL), D_MODEL ** -0.5),
        'b_gate': nrm(ks[15], (DEPTH, 2 * D_MODEL), 0.02),
        'w_out': nrm(ks[16], (DEPTH, D_MODEL, D_MODEL), D_MODEL ** -0.5),
        'ffn2_norm': 1.0 + nrm(ks[17], (DEPTH, D_MODEL), 0.02),
        'ffn2_w13': nrm(ks[18], (DEPTH, D_MODEL, 2 * D_FF), D_MODEL ** -0.5),
        'ffn2_w2': nrm(ks[19], (DEPTH, D_FF, D_MODEL), D_FF ** -0.5),
        'final_norm': 1.0 + nrm(ks[20], (D_MODEL,), 0.02),
    }


def reference(x_prompt, x_sample, ffn1_norm, ffn1_w13, ffn1_w2, mix_norm, w_in, q_norm, k_norm,
              ret_decay_fwd, ret_decay_bwd, ret_norm, w_branch_attn, w_branch_ret,
              w_gate, b_gate, w_out, ffn2_norm, ffn2_w13, ffn2_w2, final_norm):
    y_prompt = trunk(x_prompt, ffn1_norm, ffn1_w13, ffn1_w2, mix_norm, w_in, q_norm, k_norm,
                     ret_decay_fwd, ret_decay_bwd, ret_norm, w_branch_attn, w_branch_ret,
                     w_gate, b_gate, w_out, ffn2_norm, ffn2_w13, ffn2_w2, final_norm)
    y_sample = trunk(x_sample, ffn1_norm, ffn1_w13, ffn1_w2, mix_norm, w_in, q_norm, k_norm,
                     ret_decay_fwd, ret_decay_bwd, ret_norm, w_branch_attn, w_branch_ret,
                     w_gate, b_gate, w_out, ffn2_norm, ffn2_w13, ffn2_w2, final_norm)
    return (y_prompt, y_sample)
```

```cpp
#include <hip/hip_runtime.h>
#include <hip/hip_cooperative_groups.h>
#include <cstdio>
#include <cstdint>
namespace cg = cooperative_groups;
#define MULTI_LAUNCH 0
namespace pg8 {
#define PG8_LAS __attribute__((address_space(3)))
typedef unsigned short bf16_t;
typedef short bf16x8 __attribute__((ext_vector_type(8)));
typedef float f32x4 __attribute__((ext_vector_type(4)));
typedef unsigned u32x4 __attribute__((ext_vector_type(4)));
constexpr int BM = 256, BK = 64, HALF = 128, HTB = HALF * BK * 2  , STAGE_BYTES = 8 * HTB, NXCD = 8, WGM = 8;

__host__ __device__ __forceinline__ int lds_byte(int r, int c) { const int st = (r >> 4) * 2 + (c >> 5), rr = r & 15, cc = c & 31, ob = rr * 64 + cc * 2; return st * 1024 + (ob ^ (((ob >> 9) & 1) << 5)); }
__host__ __device__ __forceinline__ void stage_rc(int b, int& R, int& C) { const int st = b / 1024, sb = b % 1024, swz = sb ^ (((sb >> 9) & 1) << 5); R = (st >> 1) * 16 + swz / 64; C = (st & 1) * 32 + (swz % 64) / 2; }
__host__ __device__ __forceinline__ int perm32(int rho) { const int n = rho >> 4, i = rho & 15; return 8 * (i >> 2) + 4 * n + (i & 3); }

struct Unit { int pm, pn; };
struct Gemm { const bf16_t* A; const bf16_t* Bt; int M, N, K; };

struct StaticOrder {
    int nM, nN, nwg, G, c;
    __host__ __device__ void init(int M, int N, int G_, int c_) { nM = M / BM; nN = N / BM; nwg = nM * nN; G = G_; c = c_; }
    __host__ __device__ bool next(int i, Unit& u) const {
        const long L = (long)i * G + c; if (L >= nwg) return false;
        int wgid = (int)L; { const int q = nwg / NXCD, r = nwg % NXCD, xcd = wgid % NXCD, off = wgid / NXCD; wgid = (xcd < r ? xcd * (q + 1) : r * (q + 1) + (xcd - r) * q) + off; }
        const int nig = WGM * nN, gid = wgid / nig, fm = gid * WGM, gsz = (nM - fm) < WGM ? (nM - fm) : WGM;
        u.pm = fm + ((wgid % nig) % gsz); u.pn = (wgid % nig) / gsz; return true;
    }
    __device__ __forceinline__ void a_ready(const Unit&) const {}
    __device__ __forceinline__ void done(const Unit&) const {}
};

typedef float f32x2 __attribute__((ext_vector_type(2)));
typedef __bf16 bf16x2_cv __attribute__((ext_vector_type(2)));
__device__ __forceinline__ unsigned cvt_pk_bf16(float lo, float hi) { f32x2 v = {lo, hi}; bf16x2_cv b = __builtin_convertvector(v, bf16x2_cv); return __builtin_bit_cast(unsigned, b); }
typedef _Float16 f16x2_cv __attribute__((ext_vector_type(2)));
typedef _Float16 f16x8_cv __attribute__((ext_vector_type(8)));
__device__ __forceinline__ unsigned cvt_pk_f16(float lo, float hi) { f32x2 v = {lo, hi}; f16x2_cv h = __builtin_convertvector(v, f16x2_cv); return __builtin_bit_cast(unsigned, h); }
__device__ __forceinline__ f32x2 cvt_f16_pair(unsigned w) { return __builtin_convertvector(__builtin_bit_cast(f16x2_cv, w), f32x2); }
template <bool F16> __device__ __forceinline__ f32x4 mma16(bf16x8 a, bf16x8 b, f32x4 c) {
    if constexpr (F16) return __builtin_amdgcn_mfma_f32_16x16x32_f16(__builtin_bit_cast(f16x8_cv, a), __builtin_bit_cast(f16x8_cv, b), c, 0, 0, 0);
    else return __builtin_amdgcn_mfma_f32_16x16x32_bf16(a, b, c, 0, 0, 0);
}
typedef unsigned u32x2 __attribute__((ext_vector_type(2)));
__device__ __forceinline__ int opaque_tid() { int t = threadIdx.x; asm volatile("" : "+v"(t)); return t; }
__device__ __forceinline__ float bf_lo(unsigned w) { return __uint_as_float(w << 16); }
__device__ __forceinline__ float bf_hi(unsigned w) { return __uint_as_float(w & 0xffff0000u); }
__device__ __forceinline__ float sigmoid_f(float v) { return __builtin_amdgcn_rcpf(1.f + __builtin_amdgcn_exp2f(-1.4426950408889634f * v)); }
__device__ __forceinline__ float silu_f(float v) { return v * sigmoid_f(v); }
__device__ __forceinline__ void rows_rstd(const float* SS, int row0, int fq, float (&rstd)[8]) {
    f32x4 pr[8];
#pragma unroll
    for (int k = 0; k < 8; ++k) pr[k] = *(const f32x4*)(SS + (size_t)(row0 + (k >> 2) * HALF + (k & 3) * 16) * 16 + 4 * fq);
#pragma unroll
    for (int k = 0; k < 8; ++k) { float s = (pr[k][0] + pr[k][1]) + (pr[k][2] + pr[k][3]); s += __shfl_xor(s, 16); s += __shfl_xor(s, 32); rstd[k] = __builtin_amdgcn_rsqf(s * (1.0f / 1024.0f) + 1e-6f); }
}

__device__ __forceinline__ void unpack8(const u32x4 w, f32x4& lo, f32x4& hi) { lo[0] = bf_lo(w.x); lo[1] = bf_hi(w.x); lo[2] = bf_lo(w.y); lo[3] = bf_hi(w.y); hi[0] = bf_lo(w.z); hi[1] = bf_hi(w.z); hi[2] = bf_lo(w.w); hi[3] = bf_hi(w.w); }
__device__ __forceinline__ u32x4 pack8(const f32x4 a, const f32x4 b) { u32x4 w; w.x = cvt_pk_bf16(a[0], a[1]); w.y = cvt_pk_bf16(a[2], a[3]); w.z = cvt_pk_bf16(b[0], b[1]); w.w = cvt_pk_bf16(b[2], b[3]); return w; }
struct EpiSwiglu {
    static constexpr bool PERM = true, AFTER_DRAIN = false;
    bf16_t* H; int ldh; const float* SS;
    __device__ __forceinline__ void operator()(const f32x4 (&acc)[2][2][4][2], const Unit& u, int wr, int wc, int fr, int fq) const {
        const int row0 = u.pm * BM + wr * 64 + fr, col0 = u.pn * HALF + wc * 32 + 8 * fq;
        float rstd[8]; rows_rstd(SS, row0, fq, rstd);
#pragma unroll
        for (int ai = 0; ai < 2; ++ai)
#pragma unroll
            for (int m = 0; m < 4; ++m) {
                bf16_t* p = H + (size_t)(row0 + ai * HALF + m * 16) * ldh + col0;
                const float rs = rstd[ai * 4 + m], nrs = -1.4426950408889634f * rs, rs2 = rs * rs;
                const f32x4 a0 = acc[ai][0][m][0], a1 = acc[ai][0][m][1], b0 = acc[ai][1][m][0], b1 = acc[ai][1][m][1];
                const f32x4 t0 = a0 * nrs, t1 = a1 * nrs;
                f32x4 e0, e1;
                e0[0] = __builtin_amdgcn_exp2f(t0[0]); e0[1] = __builtin_amdgcn_exp2f(t0[1]); e0[2] = __builtin_amdgcn_exp2f(t0[2]); e0[3] = __builtin_amdgcn_exp2f(t0[3]);
                e1[0] = __builtin_amdgcn_exp2f(t1[0]); e1[1] = __builtin_amdgcn_exp2f(t1[1]); e1[2] = __builtin_amdgcn_exp2f(t1[2]); e1[3] = __builtin_amdgcn_exp2f(t1[3]);
                const f32x4 d0 = e0 + 1.0f, d1 = e1 + 1.0f, ab0 = a0 * b0, ab1 = a1 * b1;
                f32x4 r0, r1;
                r0[0] = __builtin_amdgcn_rcpf(d0[0]); r0[1] = __builtin_amdgcn_rcpf(d0[1]); r0[2] = __builtin_amdgcn_rcpf(d0[2]); r0[3] = __builtin_amdgcn_rcpf(d0[3]);
                r1[0] = __builtin_amdgcn_rcpf(d1[0]); r1[1] = __builtin_amdgcn_rcpf(d1[1]); r1[2] = __builtin_amdgcn_rcpf(d1[2]); r1[3] = __builtin_amdgcn_rcpf(d1[3]);
                const f32x4 h0 = ab0 * (r0 * rs2), h1 = ab1 * (r1 * rs2);
                u32x4 w;
                w.x = cvt_pk_bf16(h0[0], h0[1]); w.y = cvt_pk_bf16(h0[2], h0[3]); w.z = cvt_pk_bf16(h1[0], h1[1]); w.w = cvt_pk_bf16(h1[2], h1[3]);
                *(u32x4*)p = w;
            }
    }
};
struct EpiResid {
    static constexpr bool PERM = true, AFTER_DRAIN = false;
    bf16_t* XH; const float* S0; const float* S1; float* SSo; float s;
    __device__ __forceinline__ void operator()(const f32x4 (&acc)[2][2][4][2], const Unit& u, int wr, int wc, int fr, int fq) const {
        const int row0 = u.pm * BM + wr * 64 + fr, col0 = u.pn * BM + wc * 32 + 8 * fq;
        const bool first = (S0 != nullptr);
        const float* src = (u.pm < 64) ? S0 : S1;
        if (first) {
#pragma unroll
            for (int ai = 0; ai < 2; ++ai) {
                f32x4 raw[4][2][2];
#pragma unroll
                for (int m = 0; m < 4; ++m)
#pragma unroll
                    for (int bj = 0; bj < 2; ++bj) { const float* p = src + (size_t)(row0 + ai * HALF + m * 16) * 1024 + col0 + bj * HALF; raw[m][bj][0] = *(const f32x4*)p; raw[m][bj][1] = *(const f32x4*)(p + 4); }
                asm volatile("" ::: "memory");
#pragma unroll
                for (int m = 0; m < 4; ++m) {
                    float ss = 0.f;
#pragma unroll
                    for (int bj = 0; bj < 2; ++bj) {
                        const f32x4 o0 = raw[m][bj][0] + acc[ai][bj][m][0] * s, o1 = raw[m][bj][1] + acc[ai][bj][m][1] * s;
                        const f32x4 q = o0 * o0 + o1 * o1; ss += (q[0] + q[1]) + (q[2] + q[3]);
                        *(u32x4*)(XH + (size_t)(row0 + ai * HALF + m * 16) * 1024 + col0 + bj * HALF) = pack8(o0, o1);
                    }
                    ss += __shfl_xor(ss, 16); ss += __shfl_xor(ss, 32);
                    if (fq == 0) SSo[(size_t)(row0 + ai * HALF + m * 16) * 16 + u.pn * 4 + wc] = ss;
                }
                asm volatile("" ::: "memory");
            }
        } else {
#pragma unroll
            for (int ai = 0; ai < 2; ++ai) {
                u32x4 raw[4][2];
#pragma unroll
                for (int m = 0; m < 4; ++m)
#pragma unroll
                    for (int bj = 0; bj < 2; ++bj) raw[m][bj] = *(const u32x4*)(XH + (size_t)(row0 + ai * HALF + m * 16) * 1024 + col0 + bj * HALF);
                asm volatile("" ::: "memory");
#pragma unroll
                for (int m = 0; m < 4; ++m) {
                    float ss = 0.f;
#pragma unroll
                    for (int bj = 0; bj < 2; ++bj) {
                        f32x4 x0, x1; unpack8(raw[m][bj], x0, x1);
                        const f32x4 o0 = x0 + acc[ai][bj][m][0] * s, o1 = x1 + acc[ai][bj][m][1] * s;
                        const f32x4 q = o0 * o0 + o1 * o1; ss += (q[0] + q[1]) + (q[2] + q[3]);
                        *(u32x4*)(XH + (size_t)(row0 + ai * HALF + m * 16) * 1024 + col0 + bj * HALF) = pack8(o0, o1);
                    }
                    ss += __shfl_xor(ss, 16); ss += __shfl_xor(ss, 32);
                    if (fq == 0) SSo[(size_t)(row0 + ai * HALF + m * 16) * 16 + u.pn * 4 + wc] = ss;
                }
                asm volatile("" ::: "memory");
            }
        }
    }
};
__device__ __forceinline__ void sigmoid8(f32x4& v0, f32x4& v1) {
    const f32x4 t0 = v0 * -1.4426950408889634f, t1 = v1 * -1.4426950408889634f; f32x4 e0, e1;
    e0[0] = __builtin_amdgcn_exp2f(t0[0]); e0[1] = __builtin_amdgcn_exp2f(t0[1]); e0[2] = __builtin_amdgcn_exp2f(t0[2]); e0[3] = __builtin_amdgcn_exp2f(t0[3]);
    e1[0] = __builtin_amdgcn_exp2f(t1[0]); e1[1] = __builtin_amdgcn_exp2f(t1[1]); e1[2] = __builtin_amdgcn_exp2f(t1[2]); e1[3] = __builtin_amdgcn_exp2f(t1[3]);
    const f32x4 d0 = e0 + 1.0f, d1 = e1 + 1.0f;
    v0[0] = __builtin_amdgcn_rcpf(d0[0]); v0[1] = __builtin_amdgcn_rcpf(d0[1]); v0[2] = __builtin_amdgcn_rcpf(d0[2]); v0[3] = __builtin_amdgcn_rcpf(d0[3]);
    v1[0] = __builtin_amdgcn_rcpf(d1[0]); v1[1] = __builtin_amdgcn_rcpf(d1[1]); v1[2] = __builtin_amdgcn_rcpf(d1[2]); v1[3] = __builtin_amdgcn_rcpf(d1[3]);
}
struct EpiMix {
    static constexpr bool PERM = true, AFTER_DRAIN = false;
    bf16_t* T; bf16_t* U; const float* bias; const float* SS; int mode;
    template <int MODE> __device__ __forceinline__ void run(const f32x4 (&acc)[2][2][4][2], const Unit& u, int wr, int wc, int fr, int fq) const {
        const int row0 = u.pm * BM + wr * 64 + fr, col0 = u.pn * BM + wc * 32 + 8 * fq;
        float rstd[8];
        if (MODE == 1 || MODE == 2) rows_rstd(SS, row0, fq, rstd);
#pragma unroll
        for (int bj = 0; bj < 2; ++bj) {
            f32x4 bv0 = (f32x4){0.f, 0.f, 0.f, 0.f}, bv1 = bv0;
            if (MODE == 1 || MODE == 2) { bv0 = *(const f32x4*)(bias + col0 + bj * HALF); bv1 = *(const f32x4*)(bias + col0 + bj * HALF + 4); }
#pragma unroll
            for (int ai = 0; ai < 2; ++ai) {
                u32x4 tw[4], uw[4];
                if (MODE == 1 || MODE == 3) {
#pragma unroll
                    for (int m = 0; m < 4; ++m) tw[m] = *(const u32x4*)(T + (size_t)(row0 + ai * HALF + m * 16) * 1024 + col0 + bj * HALF); }
                if (MODE == 3) {
#pragma unroll
                    for (int m = 0; m < 4; ++m) uw[m] = *(const u32x4*)(U + (size_t)(row0 + ai * HALF + m * 16) * 1024 + col0 + bj * HALF); }
                asm volatile("" ::: "memory");
#pragma unroll
                for (int m = 0; m < 4; ++m) {
                    const size_t idx = (size_t)(row0 + ai * HALF + m * 16) * 1024 + col0 + bj * HALF;
                    f32x4 v0 = acc[ai][bj][m][0], v1 = acc[ai][bj][m][1];
                    if (MODE == 1 || MODE == 2) { const float rs = rstd[ai * 4 + m]; v0 = v0 * rs + bv0; v1 = v1 * rs + bv1; sigmoid8(v0, v1); }
                    if (MODE == 1) { f32x4 t0, t1; unpack8(tw[m], t0, t1); v0 = v0 * t0; v1 = v1 * t1; }
                    if (MODE == 3) { f32x4 t0, t1, g0, g1; unpack8(tw[m], t0, t1); unpack8(uw[m], g0, g1); v0 = t0 + g0 * v0; v1 = t1 + g1 * v1; }
                    u32x4 w; w.x = cvt_pk_bf16(v0[0], v0[1]); w.y = cvt_pk_bf16(v0[2], v0[3]); w.z = cvt_pk_bf16(v1[0], v1[1]); w.w = cvt_pk_bf16(v1[2], v1[3]);
                    *(u32x4*)(((MODE == 2 || MODE == 5) ? U : T) + idx) = w;
                }
                asm volatile("" ::: "memory");
            }
        }
    }
    __device__ __forceinline__ void run4(const f32x4 (&acc)[2][2][4][2], const Unit& u, int wr, int wc, int fr, int fq) const {
        const int row0 = u.pm * BM + wr * 64 + fr, mcol0 = u.pn * HALF + wc * 32 + 8 * fq;
        float rstd[8]; rows_rstd(SS, row0, fq, rstd);
        const f32x4 ba0 = *(const f32x4*)(bias + mcol0), ba1 = *(const f32x4*)(bias + mcol0 + 4), br0 = *(const f32x4*)(bias + 1024 + mcol0), br1 = *(const f32x4*)(bias + 1024 + mcol0 + 4);
#pragma unroll
        for (int ai = 0; ai < 2; ++ai) {
            u32x4 tw[4], uw[4];
#pragma unroll
            for (int m = 0; m < 4; ++m) { const size_t idx = (size_t)(row0 + ai * HALF + m * 16) * 1024 + mcol0; tw[m] = *(const u32x4*)(T + idx); uw[m] = *(const u32x4*)(U + idx); }
            asm volatile("" ::: "memory");
#pragma unroll
            for (int m = 0; m < 4; ++m) {
                const size_t idx = (size_t)(row0 + ai * HALF + m * 16) * 1024 + mcol0;
                const float rs = rstd[ai * 4 + m];
                f32x4 o0, o1;
                { f32x4 a0 = acc[ai][0][m][0] * rs + ba0, a1 = acc[ai][0][m][1] * rs + ba1; sigmoid8(a0, a1); f32x4 t0, t1; unpack8(tw[m], t0, t1); o0 = a0 * t0; o1 = a1 * t1; }
                asm volatile("" : "+v"(o0), "+v"(o1));
                { f32x4 r0 = acc[ai][1][m][0] * rs + br0, r1 = acc[ai][1][m][1] * rs + br1; sigmoid8(r0, r1); f32x4 g0, g1; unpack8(uw[m], g0, g1); o0 = o0 + r0 * g0; o1 = o1 + r1 * g1; }
                *(u32x4*)(T + idx) = pack8(o0, o1);
            }
            asm volatile("" ::: "memory");
        }
    }
    __device__ __forceinline__ void operator()(const f32x4 (&acc)[2][2][4][2], const Unit& u, int wr, int wc, int fr, int fq) const {
        if (mode == 0) run<0>(acc, u, wr, wc, fr, fq);
        else if (mode == 5) run<5>(acc, u, wr, wc, fr, fq);
        else run4(acc, u, wr, wc, fr, fq);
    }
};
struct EpiInProj {
    static constexpr bool PERM = true, AFTER_DRAIN = false;
    static constexpr size_t EMI = 524288;
    static constexpr size_t EQ = 0, EK = 48 * EMI, EV = 60 * EMI, ERQ = 72 * EMI, ERK = 96 * EMI, ERV = 120 * EMI, ERG = 168 * EMI;
    bf16_t* base; const float *qn, *kn, *SS; float qscale;
    __device__ __forceinline__ void operator()(const f32x4 (&acc)[2][2][4][2], const Unit& u, int wr, int wc, int fr, int fq) const {
        const int pn = u.pn, row0 = u.pm * BM + wr * 64 + fr;
        const bool isq = pn <= 1, isk = (pn == 2 && wc < 2), isv = (pn == 2 && wc >= 2);
        const bool do_norm = isq || isk, do_rope = isq || isk || pn == 3 || pn == 4;
        float g_lo[8], g_hi[8];
#pragma unroll
        for (int e = 0; e < 8; ++e) { g_lo[e] = 1.f; g_hi[e] = 1.f; }
        if (do_norm) { const float* g = isq ? qn : kn;
#pragma unroll
            for (int e = 0; e < 8; ++e) { g_lo[e] = g[8 * fq + e]; g_hi[e] = g[32 + 8 * fq + e]; } }
        const float post = isq ? qscale : (pn == 4 ? 0.125f : 1.f);
        size_t eo; int ld, cb;
        if (isq) { eo = EQ; ld = 512; cb = (4 * pn + wc) * 64; }
        else if (isk) { eo = EK; ld = 128; cb = wc * 64; }
        else if (isv) { eo = EV; ld = 128; cb = (wc - 2) * 64; }
        else if (pn == 3) { eo = ERQ; ld = 256; cb = wc * 64; }
        else if (pn == 4) { eo = ERK; ld = 256; cb = wc * 64; }
        else if (pn <= 6) { eo = ERV; ld = 512; cb = (pn - 5) * 256 + wc * 64; }
        else { eo = ERG; ld = 512; cb = (pn - 7) * 256 + wc * 64; }
        bf16_t* dst = base + eo;
        float rstd[8]; rows_rstd(SS, row0, fq, rstd);
        f32x4 gl0, gl1, gh0, gh1;
#pragma unroll
        for (int e = 0; e < 4; ++e) { gl0[e] = g_lo[e]; gl1[e] = g_lo[4 + e]; gh0[e] = g_hi[e]; gh1[e] = g_hi[4 + e]; }
#pragma unroll
        for (int ai = 0; ai < 2; ++ai)
#pragma unroll
            for (int m = 0; m < 4; ++m) {
                const int row = row0 + ai * HALF + m * 16;
                const float rs = rstd[ai * 4 + m];
                f32x4 lo0 = acc[ai][0][m][0] * rs, lo1 = acc[ai][0][m][1] * rs, hi0 = acc[ai][1][m][0] * rs, hi1 = acc[ai][1][m][1] * rs;
                if (do_norm) {
                    const f32x4 q = lo0 * lo0 + lo1 * lo1 + hi0 * hi0 + hi1 * hi1;
                    float ss = (q[0] + q[1]) + (q[2] + q[3]);
                    ss += __shfl_xor(ss, 16); ss += __shfl_xor(ss, 32);
                    const float hr = __builtin_amdgcn_rsqf(ss * (1.0f / 64.0f) + 1e-6f);
                    lo0 = lo0 * (gl0 * hr); lo1 = lo1 * (gl1 * hr); hi0 = hi0 * (gh0 * hr); hi1 = hi1 * (gh1 * hr);
                }
                if (do_rope) {
                    const int t = row < 16384 ? row : (row & 4095);
                    const float pf = (float)((fq < 2) ? (t >> 6) : (t & 63));
                    int fqo = fq & 1; asm volatile("" : "+v"(fqo));
                    const float fb = (float)(8 * fqo) * (-13.287712379549449f / 16.0f);
                    f32x4 x0, x1;
                    x0[0] = __builtin_amdgcn_exp2f(fb); x0[1] = __builtin_amdgcn_exp2f(fb - 1.0f * (13.287712379549449f / 16.0f)); x0[2] = __builtin_amdgcn_exp2f(fb - 2.0f * (13.287712379549449f / 16.0f)); x0[3] = __builtin_amdgcn_exp2f(fb - 3.0f * (13.287712379549449f / 16.0f));
                    x1[0] = __builtin_amdgcn_exp2f(fb - 4.0f * (13.287712379549449f / 16.0f)); x1[1] = __builtin_amdgcn_exp2f(fb - 5.0f * (13.287712379549449f / 16.0f)); x1[2] = __builtin_amdgcn_exp2f(fb - 6.0f * (13.287712379549449f / 16.0f)); x1[3] = __builtin_amdgcn_exp2f(fb - 7.0f * (13.287712379549449f / 16.0f));
                    x0 = x0 * (pf * 0.15915494309189535f); x1 = x1 * (pf * 0.15915494309189535f);
                    f32x4 r0, r1;
                    r0[0] = __builtin_rintf(x0[0]); r0[1] = __builtin_rintf(x0[1]); r0[2] = __builtin_rintf(x0[2]); r0[3] = __builtin_rintf(x0[3]);
                    r1[0] = __builtin_rintf(x1[0]); r1[1] = __builtin_rintf(x1[1]); r1[2] = __builtin_rintf(x1[2]); r1[3] = __builtin_rintf(x1[3]);
                    x0 = x0 - r0; x1 = x1 - r1;
                    f32x4 c0, c1, s0, s1;
                    c0[0] = __builtin_amdgcn_cosf(x0[0]); c0[1] = __builtin_amdgcn_cosf(x0[1]); c0[2] = __builtin_amdgcn_cosf(x0[2]); c0[3] = __builtin_amdgcn_cosf(x0[3]);
                    c1[0] = __builtin_amdgcn_cosf(x1[0]); c1[1] = __builtin_amdgcn_cosf(x1[1]); c1[2] = __builtin_amdgcn_cosf(x1[2]); c1[3] = __builtin_amdgcn_cosf(x1[3]);
                    s0[0] = __builtin_amdgcn_sinf(x0[0]); s0[1] = __builtin_amdgcn_sinf(x0[1]); s0[2] = __builtin_amdgcn_sinf(x0[2]); s0[3] = __builtin_amdgcn_sinf(x0[3]);
                    s1[0] = __builtin_amdgcn_sinf(x1[0]); s1[1] = __builtin_amdgcn_sinf(x1[1]); s1[2] = __builtin_amdgcn_sinf(x1[2]); s1[3] = __builtin_amdgcn_sinf(x1[3]);
                    const f32x4 a0 = (lo0 * c0 - hi0 * s0) * post, a1 = (lo1 * c1 - hi1 * s1) * post, b0 = (lo0 * s0 + hi0 * c0) * post, b1 = (lo1 * s1 + hi1 * c1) * post;
                    lo0 = a0; lo1 = a1; hi0 = b0; hi1 = b1;
                }
                bf16_t* p = dst + (size_t)row * ld + cb + 8 * fq;
                u32x4 w; w.x = cvt_pk_bf16(lo0[0], lo0[1]); w.y = cvt_pk_bf16(lo0[2], lo0[3]); w.z = cvt_pk_bf16(lo1[0], lo1[1]); w.w = cvt_pk_bf16(lo1[2], lo1[3]);
                *(u32x4*)p = w;
                w.x = cvt_pk_bf16(hi0[0], hi0[1]); w.y = cvt_pk_bf16(hi0[2], hi0[3]); w.z = cvt_pk_bf16(hi1[0], hi1[1]); w.w = cvt_pk_bf16(hi1[2], hi1[3]);
                *(u32x4*)(p + 32) = w;
                asm volatile("" ::: "memory");
            }
    }
};
template <class Epi, class Sched, bool ALIGN_EPI = false, bool SP2 = false>
__device__ __forceinline__ void gemm_phase(PG8_LAS unsigned char* lds, const Gemm g, const Sched& S, const Epi& E) {
    const int tid = opaque_tid(), wid = __builtin_amdgcn_readfirstlane(tid >> 6), lane = tid & 63, wr = wid >> 2, wc = wid & 3, fr = lane & 15, fq = lane >> 4;
    const int K = g.K, nt = K / BK;
    unsigned voffA[2], voffB[2];
#pragma unroll
    for (int i = 0; i < 2; ++i) { int R, C; stage_rc(tid * 16 + i * 8192, R, C); const int Rb = Epi::PERM ? ((R & ~31) + perm32(R & 31)) : R;
        voffA[i] = (unsigned)(R * K + C) * 2u; voffB[i] = (unsigned)(Rb * K + C) * 2u; }
    const size_t kstep = (size_t)(BK * 2);
    const size_t hstep = (size_t)HALF * K * 2;
    const size_t tstep = 2 * hstep;
    const unsigned ldsw = (unsigned)wid * 1024u;
    const int aoff = lds_byte(wr * 64 + fr, fq * 8), boff = lds_byte(wc * 32 + fr, fq * 8);
#define PG8_SA(b, h) (((b) * 2 + (h)) * HTB)
#define PG8_SB(b, h) ((4 + (b) * 2 + (h)) * HTB)
#define PG8_STAGE(bufoff, gbase, voff) do { _Pragma("unroll") for (int _i = 0; _i < 2; ++_i) \
        __builtin_amdgcn_global_load_lds((const unsigned*)((const char*)(gbase) + (voff)[_i]), (PG8_LAS unsigned*)(lds + (bufoff) + ldsw + _i * 8192), 16, 0, 0); } while (0)
#define PG8_LDA(dst, b, h) do { _Pragma("unroll") for (int m = 0; m < 4; ++m) _Pragma("unroll") for (int k = 0; k < 2; ++k) dst[m][k] = *(const PG8_LAS bf16x8*)(lds + PG8_SA(b, h) + aoff + m * 2048 + k * 1024); } while (0)
#define PG8_LDB(dst, b, h) do { _Pragma("unroll") for (int n = 0; n < 2; ++n) _Pragma("unroll") for (int k = 0; k < 2; ++k) dst[n][k] = *(const PG8_LAS bf16x8*)(lds + PG8_SB(b, h) + boff + n * 2048 + k * 1024); } while (0)
#define PG8_MMA(ai, bj, At, Bt) do { __builtin_amdgcn_s_setprio(1); _Pragma("unroll") for (int m = 0; m < 4; ++m) _Pragma("unroll") for (int n = 0; n < 2; ++n) _Pragma("unroll") for (int k = 0; k < 2; ++k) \
        acc[ai][bj][m][n] = __builtin_amdgcn_mfma_f32_16x16x32_bf16(Bt[n][k], At[m][k], acc[ai][bj][m][n], 0, 0, 0); __builtin_amdgcn_s_setprio(0); } while (0)
#define PG8_WAIT_V(n) asm volatile("s_waitcnt vmcnt(" #n ")" ::: "memory")
#define PG8_WAIT_L(n) asm volatile("s_waitcnt lgkmcnt(" #n ")" ::: "memory")
#define PG8_BAR __builtin_amdgcn_s_barrier()
#define PG8_SCHED __builtin_amdgcn_sched_barrier(0)
    Unit cur, nxt; int ui = 0;
    if (!S.next(0, cur)) return;
    f32x4 acc[2][2][4][2];
#pragma unroll
    for (int a = 0; a < 2; ++a)
#pragma unroll
        for (int b = 0; b < 2; ++b)
#pragma unroll
            for (int m = 0; m < 4; ++m)
#pragma unroll
                for (int n = 0; n < 2; ++n) acc[a][b][m][n] = (f32x4){0.f, 0.f, 0.f, 0.f};
    bf16x8 At[4][2], B0[2][2], B1[2][2];
    const char* cA = (const char*)g.A + (size_t)cur.pm * tstep; const char* cB = (const char*)g.Bt + (size_t)cur.pn * tstep;
    S.a_ready(cur);
    if constexpr (SP2) {
        PG8_STAGE(PG8_SB(0, 0), cB, voffB); PG8_STAGE(PG8_SB(0, 1), cB + hstep, voffB); PG8_STAGE(PG8_SA(0, 0), cA, voffA); PG8_STAGE(PG8_SA(0, 1), cA + hstep, voffA);
        if (wr == 1) PG8_BAR;
        PG8_WAIT_V(2); PG8_BAR;
        PG8_STAGE(PG8_SB(1, 0), cB + kstep, voffB); PG8_STAGE(PG8_SA(1, 0), cA + kstep, voffA); PG8_STAGE(PG8_SB(1, 1), cB + hstep + kstep, voffB);
        PG8_WAIT_V(6); PG8_BAR;
    } else {
        PG8_STAGE(PG8_SB(0, 0), cB, voffB); PG8_STAGE(PG8_SA(0, 0), cA, voffA); PG8_STAGE(PG8_SB(0, 1), cB + hstep, voffB); PG8_STAGE(PG8_SA(0, 1), cA + hstep, voffA);
        if (wr == 1) PG8_BAR;
        PG8_WAIT_V(4); PG8_BAR;
        PG8_STAGE(PG8_SB(1, 0), cB + kstep, voffB); PG8_STAGE(PG8_SA(1, 0), cA + kstep, voffA); PG8_STAGE(PG8_SB(1, 1), cB + hstep + kstep, voffB);
        PG8_WAIT_V(6); PG8_BAR;
    }
    for (;;) {
        const bool has_next = S.next(ui + 1, nxt);
        const char* nA = has_next ? (const char*)g.A + (size_t)nxt.pm * tstep : cA; const char* nB = has_next ? (const char*)g.Bt + (size_t)nxt.pn * tstep : cB;
        for (int t = 0; t < nt; t += 2) {
            const bool last = (t == nt - 2);
            const char* a1 = cA + (size_t)(t + 1) * kstep;
            const char* a2 = last ? nA : cA + (size_t)(t + 2) * kstep; const char* b2 = last ? nB : cB + (size_t)(t + 2) * kstep;
            const char* a3 = a2 + kstep; const char* b3 = b2 + kstep;
            if (last && has_next) S.a_ready(nxt);
            if constexpr (SP2) {
            PG8_LDB(B0, 0, 0); PG8_LDB(B1, 0, 1); PG8_SCHED; PG8_LDA(At, 0, 0); PG8_STAGE(PG8_SA(1, 1), a1 + hstep, voffA);
            PG8_WAIT_V(8); PG8_WAIT_L(0); PG8_BAR; PG8_MMA(0, 0, At, B0); PG8_MMA(0, 1, At, B1); PG8_BAR; PG8_SCHED;
            PG8_LDA(At, 0, 1); PG8_STAGE(PG8_SB(0, 0), b2, voffB); PG8_STAGE(PG8_SB(0, 1), b2 + hstep, voffB); PG8_STAGE(PG8_SA(0, 0), a2, voffA);
            PG8_WAIT_V(8); PG8_WAIT_L(0); PG8_BAR; PG8_MMA(1, 0, At, B0); PG8_MMA(1, 1, At, B1); PG8_BAR; PG8_SCHED;
            PG8_LDB(B0, 1, 0); PG8_LDB(B1, 1, 1); PG8_SCHED; PG8_LDA(At, 1, 0); PG8_STAGE(PG8_SA(0, 1), a2 + hstep, voffA);
            PG8_WAIT_V(8); PG8_WAIT_L(0); PG8_BAR; PG8_MMA(0, 0, At, B0); PG8_MMA(0, 1, At, B1); PG8_BAR; PG8_SCHED;
            PG8_LDA(At, 1, 1); PG8_STAGE(PG8_SB(1, 0), b3, voffB); PG8_STAGE(PG8_SB(1, 1), b3 + hstep, voffB); PG8_STAGE(PG8_SA(1, 0), a3, voffA);
            PG8_WAIT_V(8); PG8_WAIT_L(0); PG8_BAR; PG8_MMA(1, 0, At, B0); PG8_MMA(1, 1, At, B1); PG8_BAR; PG8_SCHED;
            } else {
            PG8_LDB(B0, 0, 0); PG8_SCHED; PG8_LDA(At, 0, 0); PG8_STAGE(PG8_SA(1, 1), a1 + hstep, voffA);
            PG8_WAIT_L(8); PG8_BAR; PG8_WAIT_L(0); PG8_MMA(0, 0, At, B0); PG8_BAR; PG8_SCHED;
            PG8_LDB(B1, 0, 1); PG8_STAGE(PG8_SB(0, 0), b2, voffB);
            PG8_BAR; PG8_WAIT_L(0); PG8_MMA(0, 1, At, B1); PG8_BAR;
            PG8_LDA(At, 0, 1); PG8_STAGE(PG8_SA(0, 0), a2, voffA);
            PG8_BAR; PG8_WAIT_L(0); PG8_MMA(1, 0, At, B0); PG8_BAR; PG8_SCHED;
            PG8_STAGE(PG8_SB(0, 1), b2 + hstep, voffB);
            PG8_WAIT_V(6); PG8_BAR; PG8_MMA(1, 1, At, B1); PG8_BAR;
            PG8_LDB(B0, 1, 0); PG8_SCHED; PG8_LDA(At, 1, 0); PG8_STAGE(PG8_SA(0, 1), a2 + hstep, voffA);
            PG8_WAIT_L(8); PG8_BAR; PG8_WAIT_L(0); PG8_MMA(0, 0, At, B0); PG8_BAR; PG8_SCHED;
            PG8_LDB(B1, 1, 1); PG8_STAGE(PG8_SB(1, 0), b3, voffB);
            PG8_BAR; PG8_WAIT_L(0); PG8_MMA(0, 1, At, B1); PG8_BAR;
            PG8_LDA(At, 1, 1); PG8_STAGE(PG8_SA(1, 0), a3, voffA);
            PG8_BAR; PG8_WAIT_L(0); PG8_MMA(1, 0, At, B0); PG8_BAR; PG8_SCHED;
            PG8_STAGE(PG8_SB(1, 1), b3 + hstep, voffB);
            PG8_WAIT_V(6); PG8_BAR; PG8_MMA(1, 1, At, B1); PG8_BAR;
            }
        }
        if constexpr (ALIGN_EPI) { if (wr == 0) PG8_BAR; }
        if constexpr (!Epi::AFTER_DRAIN) { E(acc, cur, wr, wc, fr, fq); S.done(cur); }
        if (!has_next) break;
#pragma unroll
        for (int a = 0; a < 2; ++a)
#pragma unroll
            for (int b = 0; b < 2; ++b)
#pragma unroll
                for (int m = 0; m < 4; ++m)
#pragma unroll
                    for (int n = 0; n < 2; ++n) acc[a][b][m][n] = (f32x4){0.f, 0.f, 0.f, 0.f};
        cur = nxt; cA = nA; cB = nB; ++ui;
        if constexpr (ALIGN_EPI) { if (wr == 1) PG8_BAR; }
    }
    PG8_WAIT_V(0);
    if constexpr (!ALIGN_EPI) { if (wr == 0) PG8_BAR; }
    PG8_BAR;
    if constexpr (Epi::AFTER_DRAIN) { E.fused(acc, cur, wr, wc, fr, fq, lds, wid, lane); S.done(cur); }
#undef PG8_SA
#undef PG8_SB
#undef PG8_STAGE
#undef PG8_LDA
#undef PG8_LDB
#undef PG8_MMA
#undef PG8_WAIT_V
#undef PG8_WAIT_L
#undef PG8_BAR
#undef PG8_SCHED
}
}
#include <hip/hip_bf16.h>
#include <cmath>
namespace attn_body {
using bf16=__hip_bfloat16;
using bf16x8=__attribute__((ext_vector_type(8)))short;
using s16x4=__attribute__((ext_vector_type(4)))short;
using f32x16=__attribute__((ext_vector_type(16)))float;
using u32x4=__attribute__((ext_vector_type(4)))unsigned;
constexpr int D=64,QP=512,KP=128;
constexpr int NW=8,QBLK=32,QB=QBLK*NW,KVBLK=64;
__device__ __forceinline__ int crow(int r,int hi){return (r&3)+8*(r>>2)+4*hi;}
#define SBAR() __builtin_amdgcn_sched_barrier(0)

constexpr int NSLOT=3, SLOTB=8192;
constexpr int LDS_K=0, LDS_V=NSLOT*SLOTB, LDS_WS=2*NSLOT*SLOTB, LDS_OST=LDS_WS+NW*64*4, LDS_BYTES=LDS_OST+NW*4096;
constexpr float C2=0.125f*1.4426950408889634f;
__device__ __forceinline__ void glds16(const void*gsrc,unsigned lds_dst){unsigned keep;
  asm volatile("s_mov_b32 %0, m0\n\ts_mov_b32 m0, %2\n\ts_nop 0\n\tglobal_load_lds_dwordx4 %1, off\n\ts_mov_b32 m0, %0":"=&s"(keep):"v"(gsrc),"s"(lds_dst):"memory");}
__device__ __forceinline__ float max3f(float a,float b,float c){float r;asm("v_max3_f32 %0, %1, %2, %3":"=v"(r):"v"(a),"v"(b),"v"(c));return r;}
__device__ __forceinline__ float max2f(float a,float b){float r;asm("v_max_f32_e32 %0, %1, %2":"=v"(r):"v"(a),"v"(b));return r;}
__device__ __forceinline__ float fadd_s(float a,float b){float r;asm("v_add_f32_e32 %0, %1, %2":"=v"(r):"v"(a),"v"(b));return r;}
__device__ __forceinline__ float fsub_s(float a,float b){float r;asm("v_sub_f32_e32 %0, %1, %2":"=v"(r):"v"(a),"v"(b));return r;}
typedef float f32x2_t __attribute__((ext_vector_type(2))); typedef __bf16 bf16x2_t __attribute__((ext_vector_type(2)));
__device__ __forceinline__ unsigned cvtpk_s(float lo,float hi){f32x2_t v={lo,hi};bf16x2_t b=__builtin_convertvector(v,bf16x2_t);return __builtin_bit_cast(unsigned,b);}
#define WAIT_BAR(N) asm volatile("s_waitcnt vmcnt(" #N ") lgkmcnt(0)\n\ts_barrier":::"memory")

__device__ __forceinline__ void qkt(f32x16&p0,f32x16&p1,const char*Kslot,const bf16x8*qr,const f32x16&negm,int r32,int hi){
  const char*kb=Kslot+hi*1024+r32*16;
  #pragma unroll
  for(int d0=0;d0<4;++d0){
    const bf16x8 b0=*reinterpret_cast<const bf16x8*>(kb+d0*2048);
    const bf16x8 b1=*reinterpret_cast<const bf16x8*>(kb+d0*2048+512);
    if(d0==0){p0=__builtin_amdgcn_mfma_f32_32x32x16_bf16(b0,qr[0],negm,0,0,0);p1=__builtin_amdgcn_mfma_f32_32x32x16_bf16(b1,qr[0],negm,0,0,0);}
    else{p0=__builtin_amdgcn_mfma_f32_32x32x16_bf16(b0,qr[d0],p0,0,0,0);p1=__builtin_amdgcn_mfma_f32_32x32x16_bf16(b1,qr[d0],p1,0,0,0);}}
}
typedef __attribute__((address_space(3))) const char* lds_cptr;
typedef short v4i16_t __attribute__((ext_vector_type(4)));
__device__ __forceinline__ void kload8(bf16x8*kf,lds_cptr kp){
  kf[0]=*(const __attribute__((address_space(3))) bf16x8*)(kp);      kf[1]=*(const __attribute__((address_space(3))) bf16x8*)(kp+512);
  kf[2]=*(const __attribute__((address_space(3))) bf16x8*)(kp+2048); kf[3]=*(const __attribute__((address_space(3))) bf16x8*)(kp+2560);
  kf[4]=*(const __attribute__((address_space(3))) bf16x8*)(kp+4096); kf[5]=*(const __attribute__((address_space(3))) bf16x8*)(kp+4608);
  kf[6]=*(const __attribute__((address_space(3))) bf16x8*)(kp+6144); kf[7]=*(const __attribute__((address_space(3))) bf16x8*)(kp+6656);
}
__device__ __forceinline__ void kload2(bf16x8*kf,lds_cptr kp,int j){ kf[2*j]=*(const __attribute__((address_space(3))) bf16x8*)(kp+j*2048); kf[2*j+1]=*(const __attribute__((address_space(3))) bf16x8*)(kp+j*2048+512); }
__device__ __forceinline__ s16x4 vtr(lds_cptr p){ return __builtin_bit_cast(s16x4,__builtin_amdgcn_ds_read_tr16_b64_v4i16((__attribute__((address_space(3))) v4i16_t*)p)); }
__device__ __forceinline__ float rowmax(const f32x16&p0,const f32x16&p1){
  float a=max3f(p0[0],p0[1],p1[0]),b=max3f(p0[2],p0[3],p1[1]);a=max3f(a,p1[2],p1[3]);
  #pragma unroll
  for(int r=4;r<16;r+=4){a=max3f(a,p0[r],p0[r+1]);b=max3f(b,p0[r+2],p0[r+3]);a=max3f(a,p1[r],p1[r+1]);b=max3f(b,p1[r+2],p1[r+3]);}
  const float m=max2f(a,b);
  auto rr=__builtin_amdgcn_permlane32_swap(__float_as_uint(m),__float_as_uint(m),false,false);
  return max2f(__uint_as_float(rr[0]),__uint_as_float(rr[1]));
}
__device__ __forceinline__ void pv(f32x16*o,int vb,bf16x8 pa0,bf16x8 pa1,bf16x8 pa2,bf16x8 pa3){
  #pragma unroll
  for(int d0=0;d0<2;++d0){s16x4 lo[4],hi[4];
    #pragma unroll
    for(int ks=0;ks<4;++ks){
      asm volatile("ds_read_b64_tr_b16 %0,%1 offset:%c2":"=&v"(lo[ks]):"v"(vb),"i"(d0*4096+ks*1024):"memory");
      asm volatile("ds_read_b64_tr_b16 %0,%1 offset:%c2":"=&v"(hi[ks]):"v"(vb),"i"(d0*4096+ks*1024+512):"memory");}
    asm volatile("s_waitcnt lgkmcnt(0)":::"memory");SBAR();
    #define PK(k) (bf16x8){lo[k][0],lo[k][1],lo[k][2],lo[k][3],hi[k][0],hi[k][1],hi[k][2],hi[k][3]}
    o[d0]=__builtin_amdgcn_mfma_f32_32x32x16_bf16(pa0,PK(0),o[d0],0,0,0);
    o[d0]=__builtin_amdgcn_mfma_f32_32x32x16_bf16(pa1,PK(1),o[d0],0,0,0);
    o[d0]=__builtin_amdgcn_mfma_f32_32x32x16_bf16(pa2,PK(2),o[d0],0,0,0);
    o[d0]=__builtin_amdgcn_mfma_f32_32x32x16_bf16(pa3,PK(3),o[d0],0,0,0);
    #undef PK
  }
}

#ifndef ATTN_STORE16
#define ATTN_STORE16(p,v) (*(u32x4*)(p)=(v))
#endif
template<int THRL> __device__ __forceinline__ void attn_unit(long rowbase,int T,int h,int qb,const bf16*Q,const bf16*__restrict__ K,const bf16*__restrict__ V,bf16*O,char*shm){
  const int tid=pg8::opaque_tid(),lane=tid&63,r32=lane&31,hi=lane>>5; const int wid=__builtin_amdgcn_readfirstlane(tid>>6);
  const int q0=qb*QB;
  const bf16*Qw=Q+(rowbase+q0+wid*QBLK)*QP+h*D;
  const bf16*Kh=K+rowbase*KP+(h>>2)*D,*Vh=V+rowbase*KP+(h>>2)*D;
  const unsigned lds0=(unsigned)(uintptr_t)shm;
  float*wsf=(float*)(shm+LDS_WS)+wid*64;
  const bf16*ksrc=Kh+(long)lane*KP+wid*8;
  const bf16*vsrc=Vh+(long)(16*(wid&3)+(lane>>2))*KP+(wid>>2)*32+(lane&3)*8;
  const unsigned kdst=lds0+LDS_K+wid*1024, vdst=lds0+LDS_V+wid*1024;
  #define DMA_K(t,slot) glds16(ksrc+(long)(t)*KVBLK*KP,(unsigned)__builtin_amdgcn_readfirstlane(kdst+(slot)))
  #define DMA_V(t,slot) glds16(vsrc+(long)(t)*KVBLK*KP,(unsigned)__builtin_amdgcn_readfirstlane(vdst+(slot)))
  const int vb0=(int)(lds0+LDS_V)+((lane>>4)&1)*32+(lane&3)*8+(4*hi+((lane&15)>>2))*64;
  const char*Kbase=shm+LDS_K; bf16x8 kf[8];
  const lds_cptr shm3=(lds_cptr)shm; const lds_cptr kp0=shm3+LDS_K+hi*1024+r32*16; const lds_cptr vp0=shm3+LDS_V+((lane>>4)&1)*32+(lane&3)*8+(4*hi+((lane&15)>>2))*64;
  const int NT=T/KVBLK;
  DMA_K(0,0);DMA_V(0,0);DMA_K(1,SLOTB);
  bf16x8 qr[4];
  #pragma unroll
  for(int d0=0;d0<4;++d0)qr[d0]=*reinterpret_cast<const bf16x8*>(&Qw[(long)r32*QP+d0*16+hi*8]);
  float mhat=0.f,l_reg=0.f;f32x16 o[2];o[0]=f32x16{};o[1]=f32x16{};f32x16 negm=f32x16{};asm volatile("":"+v"(negm));
  #define CMASK(P0,P1,t) do{}while(0)
  bool resc=false;
  #define START(P0,P1) do{ const float rm=rowmax(P0,P1); resc=false; \
    { const float dl=rm; mhat=fadd_s(mhat,dl); \
      _Pragma("unroll") for(int r=0;r<16;++r){P0[r]=fsub_s(P0[r],dl);P1[r]=fsub_s(P1[r],dl);} \
      _Pragma("unroll") for(int r=0;r<16;++r)negm[r]=-mhat; asm volatile("":"+v"(negm)); } \
    _Pragma("unroll") for(int r=0;r<16;++r)P0[r]=__builtin_amdgcn_exp2f(P0[r]); }while(0)
  #define RESC() do{ if(resc){ asm volatile("s_waitcnt lgkmcnt(0)":::"memory"); \
      _Pragma("unroll") for(int d_=0;d_<2;++d_) _Pragma("unroll") for(int r=0;r<16;++r)o[d_][r]*=wsf[crow(r,hi)]; } }while(0)
  f32x16 pA0,pA1,pB0,pB1;
  int sl_prev=0,sl_cur=0,sl_next=SLOTB;
  #define ROT() do{sl_prev=sl_cur;sl_cur=sl_next;sl_next=(sl_next==(NSLOT-1)*SLOTB)?0:sl_next+SLOTB;}while(0)
  DMA_K(2,2*SLOTB);
  WAIT_BAR(3);
  qkt(pA0,pA1,Kbase,qr,negm,r32,hi);asm volatile("s_nop 15\n\ts_nop 7":"+v"(pA0),"+v"(pA1));CMASK(pA0,pA1,0);
  START(pA0,pA1);
  _Pragma("unroll") for(int r=0;r<16;++r)pA1[r]=__builtin_amdgcn_exp2f(pA1[r]);
  WAIT_BAR(0);
  DMA_K(3,0);DMA_V(1,SLOTB);
  ROT();
  kload8(kf,kp0+sl_cur);
  WAIT_BAR(2);
  s16x4 vlo[8],vhi[8]; u32x4 pw0,pw1,pw2,pw3;
  #define PKW(P,B) cvtpk_s(P[B],P[B+1])
  #define PAF(k) __builtin_bit_cast(bf16x8,pw##k)
  #define VFR(i) (bf16x8){vlo[i][0],vlo[i][1],vlo[i][2],vlo[i][3],vhi[i][0],vhi[i][1],vhi[i][2],vhi[i][3]}
  #define PIN(x) asm volatile("":"+v"(x))
  #define MX3(a,b,c) __builtin_fmaxf(__builtin_fmaxf((a),(b)),(c))
  #define GAPA(MF,A0,A1,A2,A3,W0,W1,PW) do{ MF; sacc+=A0; sacc+=A1; sacc+=A2; sacc+=A3; PIN(sacc); W0; W1; PIN(PW); SBAR(); }while(0)
  #define EX(v) __builtin_amdgcn_exp2f(v)
  #define GAPB(MF,X,B) do{ MF; X[B]=EX(X[B]); X[B+1]=EX(X[B+1]); X[B+2]=EX(X[B+2]); X[B+3]=EX(X[B+3]); PIN(X); SBAR(); }while(0)
  #define VRD(i) do{ vlo[i]=vtr(vp_+(((i)>>2)*4096+((i)&3)*1024)); vhi[i]=vtr(vp_+(((i)>>2)*4096+((i)&3)*1024+512)); }while(0)
  #define KRD(G,j) do{ if(G){ kload2(kf,kp0+sl_next,j); SBAR(); } }while(0)
  #define STEP(C0,C1,P0,P1,t,GK,GV,GL) do{ SBAR(); \
    const lds_cptr vp_=vp0+sl_prev; \
    VRD(0); SBAR(); float sacc=(P0[0]+P0[1]); \
    GAPA(C0=__builtin_amdgcn_mfma_f32_32x32x16_bf16(kf[0],qr[0],negm,0,0,0), P0[2],P0[3],P0[4],P0[5],     pw0[0]=PKW(P0,0), pw0[1]=PKW(P0,2), pw0); \
    VRD(4); SBAR(); GAPA(C1=__builtin_amdgcn_mfma_f32_32x32x16_bf16(kf[1],qr[0],negm,0,0,0), P0[6],P0[7],P0[8],P0[9],     pw0[2]=PKW(P0,4), pw0[3]=PKW(P0,6), pw0); \
    VRD(1); SBAR(); GAPA(C0=__builtin_amdgcn_mfma_f32_32x32x16_bf16(kf[2],qr[1],C0,0,0,0),   P0[10],P0[11],P0[12],P0[13], pw1[0]=PKW(P0,8), pw1[1]=PKW(P0,10), pw1); \
    VRD(5); SBAR(); GAPA(C1=__builtin_amdgcn_mfma_f32_32x32x16_bf16(kf[3],qr[1],C1,0,0,0),   P0[14],P0[15],P1[0],P1[1],   pw1[2]=PKW(P0,12),pw1[3]=PKW(P0,14), pw1); \
    VRD(2); SBAR(); GAPA(C0=__builtin_amdgcn_mfma_f32_32x32x16_bf16(kf[4],qr[2],C0,0,0,0),   P1[2],P1[3],P1[4],P1[5],     pw2[0]=PKW(P1,0), pw2[1]=PKW(P1,2), pw2); \
    VRD(6); SBAR(); GAPA(C1=__builtin_amdgcn_mfma_f32_32x32x16_bf16(kf[5],qr[2],C1,0,0,0),   P1[6],P1[7],P1[8],P1[9],     pw2[2]=PKW(P1,4), pw2[3]=PKW(P1,6), pw2); \
    VRD(3); SBAR(); GAPA(C0=__builtin_amdgcn_mfma_f32_32x32x16_bf16(kf[6],qr[3],C0,0,0,0),   P1[10],P1[11],P1[12],P1[13], pw3[0]=PKW(P1,8), pw3[1]=PKW(P1,10), pw3); \
    VRD(7); SBAR(); GAPA(C1=__builtin_amdgcn_mfma_f32_32x32x16_bf16(kf[7],qr[3],C1,0,0,0),   P1[14],P1[15],0.f,0.f,       pw3[2]=PKW(P1,12),pw3[3]=PKW(P1,14), pw3); \
    l_reg+=sacc; \
    if(GK){DMA_K((t)+3,sl_cur);} if(GV){DMA_V((t)+1,sl_next);} \
    CMASK(C0,C1,t); \
    { float a=MX3(C0[0],C0[1],C1[0]),b=MX3(C0[2],C0[3],C1[1]); a=MX3(a,C1[2],C1[3]); \
      _Pragma("unroll") for(int r=4;r<16;r+=4){a=MX3(a,C0[r],C0[r+1]);b=MX3(b,C0[r+2],C0[r+3]);a=MX3(a,C1[r],C1[r+1]);b=MX3(b,C1[r+2],C1[r+3]);} \
      float rm=__builtin_fmaxf(a,b); { auto rr=__builtin_amdgcn_permlane32_swap(__float_as_uint(rm),__float_as_uint(rm),false,false); rm=__builtin_fmaxf(__uint_as_float(rr[0]),__uint_as_float(rr[1])); } \
      resc=false; \
      if(__builtin_expect(__any(rm>(float)THRL),0)){ const float dl=__builtin_fmaxf(rm,0.f); mhat+=dl; \
        _Pragma("unroll") for(int r=0;r<16;++r){C0[r]-=dl;C1[r]-=dl;} \
        _Pragma("unroll") for(int r=0;r<16;++r)negm[r]=-mhat; asm volatile("":"+v"(negm)); \
        const float f=__builtin_amdgcn_exp2f(-dl); l_reg*=f; if(hi==0)wsf[r32]=f; resc=true; } } \
    SBAR(); \
    GAPB(o[0]=__builtin_amdgcn_mfma_f32_32x32x16_bf16(PAF(0),VFR(0),o[0],0,0,0), C0,0); \
    GAPB(o[1]=__builtin_amdgcn_mfma_f32_32x32x16_bf16(PAF(0),VFR(4),o[1],0,0,0), C0,4); \
    KRD(GL,0); GAPB(o[0]=__builtin_amdgcn_mfma_f32_32x32x16_bf16(PAF(1),VFR(1),o[0],0,0,0), C0,8); \
    KRD(GL,1); GAPB(o[1]=__builtin_amdgcn_mfma_f32_32x32x16_bf16(PAF(1),VFR(5),o[1],0,0,0), C0,12); \
    KRD(GL,2); GAPB(o[0]=__builtin_amdgcn_mfma_f32_32x32x16_bf16(PAF(2),VFR(2),o[0],0,0,0), C1,0); \
    KRD(GL,3); GAPB(o[1]=__builtin_amdgcn_mfma_f32_32x32x16_bf16(PAF(2),VFR(6),o[1],0,0,0), C1,4); \
    GAPB(o[0]=__builtin_amdgcn_mfma_f32_32x32x16_bf16(PAF(3),VFR(3),o[0],0,0,0), C1,8); \
    GAPB(o[1]=__builtin_amdgcn_mfma_f32_32x32x16_bf16(PAF(3),VFR(7),o[1],0,0,0), C1,12); \
    }while(0)
  int t=1;
  #undef CMASK
  #define CMASK(P0,P1,t) do{}while(0)
  for(;t+5<NT;t+=2){
    STEP(pB0,pB1,pA0,pA1,t,true,true,true);     WAIT_BAR(2); RESC(); ROT();
    STEP(pA0,pA1,pB0,pB1,t+1,true,true,true);   WAIT_BAR(2); RESC(); ROT();
  }
  #undef CMASK
  #define CMASK(P0,P1,t) do{}while(0)
  #define ENDW(tt) do{ if((tt)+3<NT){WAIT_BAR(2);} else if((tt)+2<NT){WAIT_BAR(1);} else {WAIT_BAR(0);} }while(0)
  for(;t+1<NT;t+=2){
    STEP(pB0,pB1,pA0,pA1,t,(t+3<NT),(t+1<NT),(t+1<NT));       ENDW(t);   RESC(); ROT();
    STEP(pA0,pA1,pB0,pB1,t+1,(t+4<NT),(t+2<NT),(t+2<NT));     ENDW(t+1); RESC(); ROT();
  }
  STEP(pB0,pB1,pA0,pA1,NT-1,false,false,false); RESC();
  { float sacc=pB0[0]+pB0[1]; _Pragma("unroll") for(int r=2;r<16;++r)sacc+=pB0[r]; _Pragma("unroll") for(int r=0;r<16;++r)sacc+=pB1[r]; l_reg+=sacc;
    pw0=(u32x4){PKW(pB0,0),PKW(pB0,2),PKW(pB0,4),PKW(pB0,6)};pw1=(u32x4){PKW(pB0,8),PKW(pB0,10),PKW(pB0,12),PKW(pB0,14)};pw2=(u32x4){PKW(pB1,0),PKW(pB1,2),PKW(pB1,4),PKW(pB1,6)};pw3=(u32x4){PKW(pB1,8),PKW(pB1,10),PKW(pB1,12),PKW(pB1,14)};
    SBAR(); pv(o,vb0+sl_cur,PAF(0),PAF(1),PAF(2),PAF(3)); }
  #undef PKW
  #undef PAF
  #undef VFR
  #undef PIN
  #undef MX3
  #undef GAPA
  #undef GAPB
  #undef EX
  #undef VRD
  #undef KRD
  #undef STEP
  #undef ENDW
  {auto rr=__builtin_amdgcn_permlane32_swap(__float_as_uint(l_reg),__float_as_uint(l_reg),false,false);l_reg=__uint_as_float(rr[0])+__uint_as_float(rr[1]);}
  if(hi==0)wsf[32+r32]=l_reg;asm volatile("s_waitcnt lgkmcnt(0)":::"memory");
  float rli[16];
  #pragma unroll
  for(int r=0;r<16;++r)rli[r]=__builtin_amdgcn_rcpf(wsf[32+crow(r,hi)]);
  bf16*Ow=O+(rowbase+q0+wid*QBLK)*QP+h*D;
  { bf16*stg=(bf16*)(shm+LDS_OST)+wid*2048;
    #pragma unroll
    for(int r=0;r<16;++r){const int orow=crow(r,hi);
      #pragma unroll
      for(int d0=0;d0<2;++d0)stg[orow*64+d0*32+r32]=__float2bfloat16(o[d0][r]*rli[r]);}
    asm volatile("s_waitcnt lgkmcnt(0)":::"memory");
    #pragma unroll
    for(int i=0;i<4;++i){const int row=i*8+(lane>>3),ch=lane&7; const u32x4 v=*(const u32x4*)(stg+row*64+ch*8); ATTN_STORE16(Ow+(long)row*QP+ch*8,v);} }
  asm volatile("s_waitcnt lgkmcnt(0)\n\ts_barrier":::"memory");
  #undef DMA_K
  #undef DMA_V
  #undef CMASK
  #undef START
  #undef RESC
  #undef ROT
}
constexpr int ATTN_LDS_BYTES=LDS_BYTES;
#undef SBAR
#undef WAIT_BAR
}
#define LAS __attribute__((address_space(3)))
typedef unsigned short bf16_t;
typedef unsigned v4u __attribute__((ext_vector_type(4)));
typedef unsigned v2u __attribute__((ext_vector_type(2)));
typedef float f32x4 __attribute__((ext_vector_type(4)));
typedef short bf16x8 __attribute__((ext_vector_type(8)));
typedef short s16x4 __attribute__((ext_vector_type(4)));

constexpr int NWAVES = 8, NTHREADS = 512;
constexpr int M_TOK = 49152, DMODEL = 1024, DFF = 2816, NPROJ = 2304, DEPTH = 4;
constexpr int PROMPT_ROWS = 16384;
constexpr int NCHUNK = M_TOK / 128;
constexpr int NRET_ITEMS = NCHUNK * 4;
constexpr float NORM_EPS = 1e-6f;
constexpr float ATT_C2 = 0.125f * 1.4426950408889634f;

constexpr size_t OW13A = 0, OW2A = OW13A + (size_t)5632 * 1024, OWIN = OW2A + (size_t)1024 * 2816, OWG = OWIN + (size_t)2304 * 1024, OWBA = OWG + (size_t)2048 * 1024,
                 OWBR = OWBA + (size_t)1024 * 512, OWO = OWBR + (size_t)1024 * 512, OW13B = OWO + (size_t)1024 * 1024, OW2B = OW13B + (size_t)5632 * 1024, OWEND = OW2B + (size_t)1024 * 2816;
constexpr size_t MiB = 1u << 20;
constexpr size_t WS_ROPE = 0;
constexpr size_t WS_BAR = 65536;
constexpr int LDS_MISC = 131072;
constexpr size_t WS_WB = 1 * MiB;
constexpr size_t WS_XN = 48 * MiB;
constexpr size_t WS_B = 144 * MiB;
constexpr size_t WS_HB = WS_B;
constexpr size_t WS_Q = WS_B, WS_K = WS_B + 48 * MiB, WS_V = WS_B + 60 * MiB, WS_RQ = WS_B + 72 * MiB, WS_RK = WS_B + 96 * MiB, WS_RV = WS_B + 120 * MiB, WS_RG = WS_B + 168 * MiB,
                 WS_T = WS_B + 216 * MiB, WS_ST = WS_B + 312 * MiB, WS_U = WS_B;
constexpr size_t WS_SS = WS_B + 360 * MiB;
constexpr size_t WS_WB1 = WS_SS + 3 * MiB;
constexpr size_t WS_END = WS_WB1 + 46 * MiB;
static_assert(OWEND * 2 + WS_WB <= WS_XN && (size_t)M_TOK * DFF * 2 <= 264 * MiB, "ws map");
static_assert(WS_Q == WS_B + 2 * pg8::EpiInProj::EQ && WS_K == WS_B + 2 * pg8::EpiInProj::EK && WS_V == WS_B + 2 * pg8::EpiInProj::EV && WS_RQ == WS_B + 2 * pg8::EpiInProj::ERQ && WS_RK == WS_B + 2 * pg8::EpiInProj::ERK && WS_RV == WS_B + 2 * pg8::EpiInProj::ERV && WS_RG == WS_B + 2 * pg8::EpiInProj::ERG, "in-proj epilogue offsets");

constexpr int LDS_BYTES = 147456;
constexpr int NPHASE = 1 + 11 * DEPTH + 1;

__device__ __forceinline__ unsigned f2bf(float f) { unsigned u = __builtin_bit_cast(unsigned, f); return (u + 0x7fffu + ((u >> 16) & 1u)) >> 16; }
__device__ __forceinline__ unsigned pk2(float lo, float hi) { return pg8::cvt_pk_bf16(lo, hi); }
__device__ __forceinline__ float bfl(unsigned w) { return __uint_as_float(w << 16); }
__device__ __forceinline__ float bfh(unsigned w) { return __uint_as_float(w & 0xffff0000u); }
__device__ __forceinline__ float wave_sum(float v) {
#pragma unroll
    for (int o = 1; o < 64; o <<= 1) v += __shfl_xor(v, o);
    return v;
}
#define LDS_WAIT() asm volatile("s_waitcnt lgkmcnt(0)" ::: "memory")

#define RLX_AGENT __ATOMIC_RELAXED, __HIP_MEMORY_SCOPE_AGENT
#define XB_TMO      128
#define XB_XCNT(j)  (256  + 64 * (j))
#define XB_XSUB(j)  (1280 + 64 * (j))
#define XB_XGEN(j)  (2304 + 64 * (j))
#define XB_TOP      3328
#define XB_TOPGEN   3392
#define XCD_BAR_WORDS 3456
#define XB_SPIN_CAP (1u << 18)

__device__ __forceinline__ unsigned xb_ld(unsigned* p)              { return __hip_atomic_load(p, __ATOMIC_RELAXED, __HIP_MEMORY_SCOPE_AGENT); }
__device__ __forceinline__ unsigned xb_add(unsigned* p, unsigned v) { return __hip_atomic_fetch_add(p, v, __ATOMIC_RELAXED, __HIP_MEMORY_SCOPE_AGENT); }
__device__ __forceinline__ unsigned xb_xcc_id() { return (unsigned)__builtin_amdgcn_s_getreg((3 << 11) | 20) & 0xFu; }
#define XB_SPIN(cond, bar) do { unsigned _sp = 0; while (cond) { __builtin_amdgcn_s_sleep(1); \
    if ((++_sp & 255u) == 0u) { if (xb_ld(&(bar)[XB_TMO])) break; if (_sp > XB_SPIN_CAP) { atomicAdd(&(bar)[XB_TMO], 1u); break; } } } } while (0)

struct XcdBarrier {
    unsigned* bar; unsigned x;
    volatile LAS unsigned* st;
};

__device__ __forceinline__ XcdBarrier xcd_barrier_post(unsigned* bar, volatile LAS unsigned* st) {
    XcdBarrier b; b.bar = bar; b.x = xb_xcc_id(); b.st = st;
    if (threadIdx.x == 0) (void)xb_add(&bar[XB_XCNT(b.x)], 1u);
    return b;
}
__device__ __forceinline__ void xcd_barrier_complete(unsigned* bar, unsigned x, unsigned& nloc, unsigned& nx) {
    const unsigned G = gridDim.x * gridDim.y * gridDim.z;
    unsigned sum, cnt, mine, sp = 0u;
    for (;;) {
        sum = 0u; cnt = 0u; mine = 0u;
#pragma unroll
        for (unsigned j = 0; j < 16; ++j) { const unsigned c = xb_ld(&bar[XB_XCNT(j)]); sum += c; cnt += (c > 0u) ? 1u : 0u; mine = (j == x) ? c : mine; }
        if (sum == G) break;
        __builtin_amdgcn_s_sleep(1);
        if ((++sp & 255u) == 0u) { if (xb_ld(&bar[XB_TMO])) break; if (sp > XB_SPIN_CAP) { atomicAdd(&bar[XB_TMO], 1u); break; } }
    }
    nloc = mine > 0u ? mine : 1u; nx = cnt > 0u ? cnt : 1u;
}

__device__ __forceinline__ void xcd_barrier(const XcdBarrier& b) {
    asm volatile("s_waitcnt vmcnt(0)" ::: "memory");
    __syncthreads();
    if (threadIdx.x == 0) {
        unsigned* bar = b.bar;
        __builtin_amdgcn_s_waitcnt(0);
        unsigned nloc = b.st[0], nx = b.st[1];
        if (nloc == 0u) { xcd_barrier_complete(bar, b.x, nloc, nx); b.st[0] = nloc; b.st[1] = nx; }
        const unsigned old = xb_add(&bar[XB_XSUB(b.x)], 1u);
        const unsigned gen = old / nloc;
        if (old + 1u == (gen + 1u) * nloc) {
            __builtin_amdgcn_fence(__ATOMIC_RELEASE, "agent");
            asm volatile("s_waitcnt vmcnt(0)" ::: "memory");
            const unsigned og = xb_add(&bar[XB_TOP], 1u);
            const unsigned tg = og / nx;
            if (og + 1u == (tg + 1u) * nx) xb_add(&bar[XB_TOPGEN], 1u);
            else XB_SPIN(xb_ld(&bar[XB_TOPGEN]) == tg, bar);
            __builtin_amdgcn_fence(__ATOMIC_ACQUIRE, "agent");
            xb_add(&bar[XB_XGEN(b.x)], 1u);
            asm volatile("s_waitcnt vmcnt(0)" ::: "memory");
        } else {
            XB_SPIN(xb_ld(&bar[XB_XGEN(b.x)]) == gen, bar);
            __builtin_amdgcn_fence(__ATOMIC_ACQUIRE, "agent");
            asm volatile("s_waitcnt vmcnt(0)" ::: "memory");
        }
    }
    __syncthreads();
}

__device__ __forceinline__ void transpose_item(const float* W, const float* gk, int K, int N, bf16_t* WT, int map, LAS float* scr, int item, int lane) {
    const int nblk = N / 32, kb = item / nblk, nb = item % nblk, k0 = 64 * kb, n0 = 32 * nb;
    int drow0 = n0;
    if (map == 1) { const int half = n0 / DFF, j = n0 % DFF; drow0 = 256 * (j / 128) + 128 * half + (j % 128); }
    else if (map == 3) { const int half = n0 / 1024, j = n0 % 1024; drow0 = 256 * (j / 128) + 128 * half + (j % 128); }
    else if (map == 2) { const int pn = n0 / 256, r = n0 % 256; drow0 = 256 * pn + 128 * ((r % 64) / 32) + 32 * (r / 64); }
    { const int kr = lane >> 3, nq = (lane & 7) * 4;
        f32x4 v[8]; float gs[8];
#pragma unroll
        for (int i = 0; i < 8; ++i) { v[i] = *(const f32x4*)(W + (size_t)(k0 + 8 * i + kr) * N + n0 + nq); gs[i] = gk ? gk[k0 + 8 * i + kr] : 1.f; }
#pragma unroll
        for (int i = 0; i < 8; ++i) { LAS float* d = scr + (8 * i + kr) * 33 + nq; d[0] = v[i][0] * gs[i]; d[1] = v[i][1] * gs[i]; d[2] = v[i][2] * gs[i]; d[3] = v[i][3] * gs[i]; } }
    LDS_WAIT(); asm volatile("" ::: "memory");
    const int c = lane & 7;
#pragma unroll
    for (int j = 0; j < 4; ++j) { const int n = (lane >> 3) + 8 * j; const LAS float* s = scr + (8 * c) * 33 + n;
        v4u o; o.x = pk2(s[0 * 33], s[1 * 33]); o.y = pk2(s[2 * 33], s[3 * 33]); o.z = pk2(s[4 * 33], s[5 * 33]); o.w = pk2(s[6 * 33], s[7 * 33]);
        *(v4u*)(WT + (size_t)(drow0 + n) * K + k0 + 8 * c) = o; }
    LDS_WAIT(); asm volatile("" ::: "memory");
}

struct Args { const float* in[21]; float* out; unsigned char* ws; int ph_lo, ph_hi; };

template <bool OUT_F32> __device__ __forceinline__ void norm_row(const float* xrow, const float* g, bf16_t* orow, float* orow_f, int lane) {
    const f32x4* xr = (const f32x4*)xrow + lane; const f32x4* gr = (const f32x4*)g + lane;
    f32x4 v[4]; float s = 0.f;
#pragma unroll
    for (int j = 0; j < 4; ++j) { v[j] = xr[64 * j]; s += (v[j].x * v[j].x + v[j].y * v[j].y) + (v[j].z * v[j].z + v[j].w * v[j].w); }
    const float rstd = 1.0f / sqrtf(wave_sum(s) * (1.0f / 1024.0f) + NORM_EPS);
#pragma unroll
    for (int j = 0; j < 4; ++j) { const f32x4 gg = gr[64 * j]; const f32x4 o = v[j] * rstd * gg;
        if (OUT_F32) ((f32x4*)orow_f)[64 * j + lane] = o;
        else { v2u w; w.x = pk2(o.x, o.y); w.y = pk2(o.z, o.w); ((v2u*)orow)[64 * j + lane] = w; } }
}

__device__ __forceinline__ void final_row(const bf16_t* hrow, const float* ssrow, const float* g, float* orow, int lane) {
    const f32x4* sp = (const f32x4*)ssrow; const f32x4 a = sp[0], b = sp[1], c = sp[2], d = sp[3];
    const float s = ((a[0] + a[1]) + (a[2] + a[3])) + ((b[0] + b[1]) + (b[2] + b[3])) + ((c[0] + c[1]) + (c[2] + c[3])) + ((d[0] + d[1]) + (d[2] + d[3]));
    const float rstd = __builtin_amdgcn_rsqf(s * (1.0f / 1024.0f) + NORM_EPS);
#pragma unroll
    for (int j = 0; j < 2; ++j) { const v4u hw = ((const v4u*)hrow)[64 * j + lane]; const int cc = 8 * (64 * j + lane);
        f32x4 x0, x1; x0[0] = bfl(hw.x); x0[1] = bfh(hw.x); x0[2] = bfl(hw.y); x0[3] = bfh(hw.y); x1[0] = bfl(hw.z); x1[1] = bfh(hw.z); x1[2] = bfl(hw.w); x1[3] = bfh(hw.w);
        const f32x4 g0 = *(const f32x4*)(g + cc), g1 = *(const f32x4*)(g + cc + 4);
        *(f32x4*)(orow + cc) = x0 * rstd * g0; *(f32x4*)(orow + cc + 4) = x1 * rstd * g1; }
}

__device__ __forceinline__ float log2_gamma(float logit) { return log1pf(-expf(logit)) * 1.4426950408889634f; }

__device__ __forceinline__ f32x4 mfma16(bf16x8 a, bf16x8 b, f32x4 c) { return __builtin_amdgcn_mfma_f32_16x16x32_bf16(a, b, c, 0, 0, 0); }

__device__ __forceinline__ void ret_local_states(LAS unsigned char* lds, const bf16_t* RK, const bf16_t* RV, bf16_t* ST, const float* dec_f, const float* dec_b, int G, int bx, int tid) {
    LAS bf16_t* KTF = (LAS bf16_t*)lds; LAS bf16_t* KTB = KTF + 64 * 136; LAS bf16_t* VT = KTB + 64 * 136;
    const int lane = tid & 63, w = tid >> 6, fr = lane & 15, fq = lane >> 4;
    for (int it = bx; it < NRET_ITEMS; it += G) {
        const int ng = it >> 2, h = it & 3, row0 = ng * 128;
        const float lgf = log2_gamma(dec_f[h]), lgb = log2_gamma(dec_b[h]);
        v4u kw[2], vw[4];
#pragma unroll
        for (int r = 0; r < 2; ++r) { const int idx = tid + 512 * r, j = idx & 127, dc = idx >> 7; kw[r] = *(const v4u*)(RK + (size_t)(row0 + j) * 256 + h * 64 + 8 * dc); }
#pragma unroll
        for (int r = 0; r < 4; ++r) { const int idx = tid + 512 * r, j = idx & 127, ec = idx >> 7; vw[r] = *(const v4u*)(RV + (size_t)(row0 + j) * 512 + h * 128 + 8 * ec); }
#pragma unroll
        for (int r = 0; r < 2; ++r) { const int idx = tid + 512 * r, j = idx & 127, dc = idx >> 7;
            const v4u wv = kw[r];
            const float df = __builtin_amdgcn_exp2f((float)(127 - j) * lgf), db = __builtin_amdgcn_exp2f((float)j * lgb);
            float v[8]; v[0] = bfl(wv.x); v[1] = bfh(wv.x); v[2] = bfl(wv.y); v[3] = bfh(wv.y); v[4] = bfl(wv.z); v[5] = bfh(wv.z); v[6] = bfl(wv.w); v[7] = bfh(wv.w);
#pragma unroll
            for (int i = 0; i < 8; ++i) { KTF[(8 * dc + i) * 136 + j] = (bf16_t)f2bf(v[i] * df); KTB[(8 * dc + i) * 136 + j] = (bf16_t)f2bf(v[i] * db); } }
#pragma unroll
        for (int r = 0; r < 4; ++r) { const int idx = tid + 512 * r, j = idx & 127, ec = idx >> 7;
            const v4u wv = vw[r];
            const unsigned ww[4] = {wv.x, wv.y, wv.z, wv.w};
#pragma unroll
            for (int i = 0; i < 4; ++i) { VT[(8 * ec + 2 * i) * 136 + j] = (bf16_t)(ww[i] & 0xffffu); VT[(8 * ec + 2 * i + 1) * 136 + j] = (bf16_t)(ww[i] >> 16); } }
        __syncthreads();
        f32x4 af[4], ab[4];
#pragma unroll
        for (int d = 0; d < 4; ++d) { af[d] = (f32x4){0.f, 0.f, 0.f, 0.f}; ab[d] = af[d]; }
#pragma unroll
        for (int s = 0; s < 4; ++s) {
            const bf16x8 vb = *(const LAS bf16x8*)(VT + (16 * w + fr) * 136 + 32 * s + 8 * fq);
#pragma unroll
            for (int d = 0; d < 4; ++d) {
                const bf16x8 kf = *(const LAS bf16x8*)(KTF + (16 * d + fr) * 136 + 32 * s + 8 * fq);
                const bf16x8 kb = *(const LAS bf16x8*)(KTB + (16 * d + fr) * 136 + 32 * s + 8 * fq);
                af[d] = mfma16(kf, vb, af[d]); ab[d] = mfma16(kb, vb, ab[d]);
            }
        }
        bf16_t* so = ST + (size_t)it * 16384 + (size_t)(16 * w + fr) * 64 + 4 * fq;
#pragma unroll
        for (int d = 0; d < 4; ++d) {
            v2u o; o.x = pk2(af[d][0], af[d][1]); o.y = pk2(af[d][2], af[d][3]); *(v2u*)(so + 16 * d) = o;
            o.x = pk2(ab[d][0], ab[d][1]); o.y = pk2(ab[d][2], ab[d][3]); *(v2u*)(so + 8192 + 16 * d) = o;
        }
        __syncthreads();
    }
}

__device__ __forceinline__ void ret_chain(bf16_t* ST, int cbase, int N, int h, int dir, int v, float cd) {
    float S[8];
#pragma unroll
    for (int e = 0; e < 8; ++e) S[e] = 0.f;
    for (int n0 = 0; n0 < N; n0 += 16) {
        v4u L[16];
#pragma unroll
        for (int k = 0; k < 16; ++k) { const int n = n0 + k, c = dir ? (N - 1 - n) : n; L[k] = *(const v4u*)(ST + ((size_t)((cbase + c) * 4 + h)) * 16384 + dir * 8192 + v * 8); }
        asm volatile("s_waitcnt vmcnt(0)" ::: "memory");
#pragma unroll
        for (int k = 0; k < 16; ++k) { const int n = n0 + k, c = dir ? (N - 1 - n) : n;
            v4u o; o.x = pk2(S[0], S[1]); o.y = pk2(S[2], S[3]); o.z = pk2(S[4], S[5]); o.w = pk2(S[6], S[7]);
            *(v4u*)(ST + ((size_t)((cbase + c) * 4 + h)) * 16384 + dir * 8192 + v * 8) = o;
            S[0] = S[0] * cd + bfl(L[k].x); S[1] = S[1] * cd + bfh(L[k].x); S[2] = S[2] * cd + bfl(L[k].y); S[3] = S[3] * cd + bfh(L[k].y);
            S[4] = S[4] * cd + bfl(L[k].z); S[5] = S[5] * cd + bfh(L[k].z); S[6] = S[6] * cd + bfl(L[k].w); S[7] = S[7] * cd + bfh(L[k].w); }
    }
}
__device__ __forceinline__ void ret_scan(bf16_t* ST, const float* dec_f, const float* dec_b, int G, int bx, int tid) {
    if (tid < 32) {
        for (int task = bx * 32 + tid; task < 8192; task += G * 32) { const int v = task & 1023, dir = (task >> 10) & 1, h = task >> 11;
            const float cd = __builtin_amdgcn_exp2f(128.f * log2_gamma(dir ? dec_b[h] : dec_f[h])); ret_chain(ST, 0, 128, h, dir, v, cd); }
    } else if (tid >= 64 && tid < 320) {
        for (int task = bx * 256 + (tid - 64); task < 65536; task += G * 256) { const int v = task & 1023, dir = (task >> 10) & 1, h = (task >> 11) & 3, sq = task >> 13;
            const float cd = __builtin_amdgcn_exp2f(128.f * log2_gamma(dir ? dec_b[h] : dec_f[h])); ret_chain(ST, 128 + 32 * sq, 32, h, dir, v, cd); }
    }
}

__device__ __forceinline__ void ret_outputs(LAS unsigned char* lds, const bf16_t* RQ, const bf16_t* RK, const bf16_t* RV, bf16_t* RG, const bf16_t* ST, const float* dec_f, const float* dec_b, const float* rnorm, int G, int bx, int tid) {
    LAS bf16_t* QS = (LAS bf16_t*)lds; LAS bf16_t* KS = QS + 128 * 72; LAS bf16_t* VT = KS + 128 * 72; LAS bf16_t* SS = VT + 128 * 136;
    const int lane = tid & 63, w = tid >> 6, fr = lane & 15, fq = lane >> 4;
    for (int it = bx; it < NRET_ITEMS; it += G) {
        const int ng = it >> 2, h = it & 3, row0 = ng * 128;
        const float lgf = log2_gamma(dec_f[h]), lgb = log2_gamma(dec_b[h]);
        v4u qw[2], kw[2], sf[2], sb[2], vw[4];
#pragma unroll
        for (int r = 0; r < 2; ++r) { const int idx = tid + 512 * r, j = idx >> 3, c = idx & 7;
            qw[r] = *(const v4u*)(RQ + (size_t)(row0 + j) * 256 + h * 64 + 8 * c);
            kw[r] = *(const v4u*)(RK + (size_t)(row0 + j) * 256 + h * 64 + 8 * c);
            sf[r] = *(const v4u*)(ST + (size_t)it * 16384 + j * 64 + 8 * c);
            sb[r] = *(const v4u*)(ST + (size_t)it * 16384 + 8192 + j * 64 + 8 * c); }
#pragma unroll
        for (int r = 0; r < 4; ++r) { const int idx = tid + 512 * r, j = idx & 127, ec = idx >> 7; vw[r] = *(const v4u*)(RV + (size_t)(row0 + j) * 512 + h * 128 + 8 * ec); }
#pragma unroll
        for (int r = 0; r < 2; ++r) { const int idx = tid + 512 * r, j = idx >> 3, c = idx & 7;
            *(LAS v4u*)(QS + j * 72 + 8 * c) = qw[r]; *(LAS v4u*)(KS + j * 72 + 8 * c) = kw[r];
            *(LAS v4u*)(SS + j * 72 + 8 * c) = sf[r]; *(LAS v4u*)(SS + 128 * 72 + j * 72 + 8 * c) = sb[r]; }
#pragma unroll
        for (int r = 0; r < 4; ++r) { const int idx = tid + 512 * r, j = idx & 127, ec = idx >> 7;
            const v4u wv = vw[r];
            const unsigned ww[4] = {wv.x, wv.y, wv.z, wv.w};
#pragma unroll
            for (int i = 0; i < 4; ++i) { VT[(8 * ec + 2 * i) * 136 + j] = (bf16_t)(ww[i] & 0xffffu); VT[(8 * ec + 2 * i + 1) * 136 + j] = (bf16_t)(ww[i] >> 16); } }
        __syncthreads();
        const int i0 = 16 * w, il = i0 + fr;
        bf16x8 qf[2];
#pragma unroll
        for (int s = 0; s < 2; ++s) qf[s] = *(const LAS bf16x8*)(QS + il * 72 + 32 * s + 8 * fq);
        f32x4 pt[8];
#pragma unroll
        for (int jb = 0; jb < 8; ++jb) { pt[jb] = (f32x4){0.f, 0.f, 0.f, 0.f};
#pragma unroll
            for (int s = 0; s < 2; ++s) { const bf16x8 kf = *(const LAS bf16x8*)(KS + (16 * jb + fr) * 72 + 32 * s + 8 * fq); pt[jb] = mfma16(kf, qf[s], pt[jb]); }
#pragma unroll
            for (int r = 0; r < 4; ++r) { const int j = 16 * jb + 4 * fq + r, diff = il - j;
                const float f = diff >= 0 ? __builtin_amdgcn_exp2f((float)diff * lgf) : __builtin_amdgcn_exp2f((float)(-diff) * lgb); pt[jb][r] *= f; } }
        bf16x8 pf[4];
#pragma unroll
        for (int s2 = 0; s2 < 4; ++s2) { v4u p; p.x = pk2(pt[2 * s2][0], pt[2 * s2][1]); p.y = pk2(pt[2 * s2][2], pt[2 * s2][3]); p.z = pk2(pt[2 * s2 + 1][0], pt[2 * s2 + 1][1]); p.w = pk2(pt[2 * s2 + 1][2], pt[2 * s2 + 1][3]);
            pf[s2] = __builtin_bit_cast(bf16x8, p); }
        f32x4 o[8];
        const float cf = __builtin_amdgcn_exp2f((float)(il + 1) * lgf), cb = __builtin_amdgcn_exp2f((float)(128 - il) * lgb);
#pragma unroll
        for (int eb = 0; eb < 8; ++eb) { o[eb] = (f32x4){0.f, 0.f, 0.f, 0.f};
#pragma unroll
            for (int s2 = 0; s2 < 4; ++s2) { const s16x4 lo = *(const LAS s16x4*)(VT + (16 * eb + fr) * 136 + 32 * s2 + 4 * fq), hi = *(const LAS s16x4*)(VT + (16 * eb + fr) * 136 + 32 * s2 + 16 + 4 * fq);
                const bf16x8 vf = __builtin_shufflevector(lo, hi, 0, 1, 2, 3, 4, 5, 6, 7); o[eb] = mfma16(vf, pf[s2], o[eb]); }
            f32x4 tf = (f32x4){0.f, 0.f, 0.f, 0.f}, tb = tf;
#pragma unroll
            for (int s = 0; s < 2; ++s) { const bf16x8 sf = *(const LAS bf16x8*)(SS + (16 * eb + fr) * 72 + 32 * s + 8 * fq), sb = *(const LAS bf16x8*)(SS + 128 * 72 + (16 * eb + fr) * 72 + 32 * s + 8 * fq);
                tf = mfma16(sf, qf[s], tf); tb = mfma16(sb, qf[s], tb); }
            o[eb] = o[eb] + tf * cf + tb * cb; }
        float sum = 0.f;
#pragma unroll
        for (int eb = 0; eb < 8; ++eb) sum += (o[eb][0] + o[eb][1]) + (o[eb][2] + o[eb][3]);
        sum += __shfl_xor(sum, 16); sum += __shfl_xor(sum, 32);
        const float mu = sum * (1.0f / 128.0f); float q = 0.f;
#pragma unroll
        for (int eb = 0; eb < 8; ++eb) { const f32x4 d = o[eb] - mu; q += (d[0] * d[0] + d[1] * d[1]) + (d[2] * d[2] + d[3] * d[3]); }
        q += __shfl_xor(q, 16); q += __shfl_xor(q, 32);
        const float rstd = 1.0f / sqrtf(q * (1.0f / 128.0f) + NORM_EPS);
        bf16_t* gp = RG + (size_t)(row0 + il) * 512 + h * 128 + 4 * fq;
#pragma unroll
        for (int eb = 0; eb < 8; ++eb) { const v2u gw = *(const v2u*)(gp + 16 * eb); const f32x4 rn = *(const f32x4*)(rnorm + h * 128 + 16 * eb + 4 * fq);
            const f32x4 y = (o[eb] - mu) * rstd * rn;
            v2u ow; ow.x = pk2(pg8::silu_f(bfl(gw.x)) * y[0], pg8::silu_f(bfh(gw.x)) * y[1]); ow.y = pk2(pg8::silu_f(bfl(gw.y)) * y[2], pg8::silu_f(bfh(gw.y)) * y[3]);
            *(v2u*)(gp + 16 * eb) = ow; }
        __syncthreads();
    }
}

__device__ __forceinline__ bool attn_unit_of(int G, int bx, int i, long& rowbase, int& T, int& h, int& qb) {
    if (G == 256) {
        if (i >= 6) return false;
        const int x = bx & 7, c = bx >> 3;
        if (i < 2) { rowbase = 0; T = PROMPT_ROWS; h = x; qb = 2 * c + i; }
        else { const int u = 4 * c + (i - 2); rowbase = PROMPT_ROWS + (long)x * 4096; T = 4096; h = u >> 4; qb = u & 15; }
        return true;
    }
    const int u = bx + i * G; if (u >= 1536) return false;
    if (u < 512) { rowbase = 0; T = PROMPT_ROWS; h = u >> 6; qb = u & 63; }
    else { const int v = u - 512, sq = v >> 7, w = v & 127; rowbase = PROMPT_ROWS + (long)sq * 4096; T = 4096; h = w >> 4; qb = w & 15; }
    return true;
}

__global__ void __launch_bounds__(NTHREADS, 2) fwd_kernel(Args args) {
    extern __shared__ __attribute__((aligned(16))) unsigned char lds_raw[];
    cg::grid_group grid = cg::this_grid();
    if (threadIdx.x < 64) ((LAS unsigned*)lds_raw)[LDS_MISC / 4 + threadIdx.x] = 0u;
    __syncthreads();
    typedef const __attribute__((address_space(4))) Args* KArgs;
    KArgs ka = (KArgs)__builtin_amdgcn_kernarg_segment_ptr();
#if MULTI_LAUNCH
    const int ph_lo = ka->ph_lo, ph_hi = ka->ph_hi;
#else
    constexpr int ph_lo = 0, ph_hi = NPHASE;
#endif

#ifdef DUP_MASK
    for (int step = 2 * ph_lo; step < 2 * ph_hi; ++step) {
        const int ph = step >> 1; const bool dry = !(step & 1);
        { int dsub = -1; if (ph >= 1 && ph < NPHASE - 1) { const int q = (ph - 1) % 10; dsub = q < 2 ? q + 1 : q < 8 ? q + 2 : q + 3; }
          if (dry && !(dsub >= 0 && ((DUP_MASK >> dsub) & 1))) continue; }
#else
    for (int ph = ph_lo; ph < ph_hi; ++ph) {
        const bool dry = false;
#endif
        asm volatile("" : "+s"(ka) :: "memory");
        const int tid = pg8::opaque_tid(), lane = tid & 63, wave = __builtin_amdgcn_readfirstlane(tid >> 6);
        int G = gridDim.x, bx = blockIdx.x; asm volatile("" : "+s"(G), "+s"(bx));
        const int gw = bx * NWAVES + wave, NGW = G * NWAVES;
        LAS unsigned char* lds = (LAS unsigned char*)lds_raw;
#define AIN(k) ((const float*)ka->in[k])
        unsigned char* const ws = ka->ws;
        float* const X = ka->out;
#define XN ((bf16_t*)(ws + WS_XN))
#define HB ((bf16_t*)(ws + WS_HB))
#define Qb ((bf16_t*)(ws + WS_Q))
#define Kb ((bf16_t*)(ws + WS_K))
#define Vb ((bf16_t*)(ws + WS_V))
#define RQ ((bf16_t*)(ws + WS_RQ))
#define RK ((bf16_t*)(ws + WS_RK))
#define RV ((bf16_t*)(ws + WS_RV))
#define RG ((bf16_t*)(ws + WS_RG))
#define Tb ((bf16_t*)(ws + WS_T))
#define Ub ((bf16_t*)(ws + WS_U))
#define ST ((bf16_t*)(ws + WS_ST))
#define SSF ((float*)(ws + WS_SS))
        const bool is_layer = (ph >= 1 && ph < NPHASE - 1);
        const int l = is_layer ? (ph - 1) / 11 : 0, s11 = is_layer ? (ph - 1) % 11 : -1;
        const int sub = !is_layer ? -1 : (int)((0xCB9D8765421ull >> (4 * s11)) & 15ull);
        bf16_t* const WB = (bf16_t*)(ws + ((l & 1) ? WS_WB1 : WS_WB));
        if (ph == 0) {
            for (int m = gw; m < M_TOK; m += NGW) {
                const f32x4* xr = (const f32x4*)(m < PROMPT_ROWS ? AIN(0) + (size_t)m * DMODEL : AIN(1) + (size_t)(m - PROMPT_ROWS) * DMODEL) + lane;
                v2u* bo = (v2u*)(XN + (size_t)m * DMODEL) + lane;
                float s = 0.f;
#pragma unroll
                for (int j = 0; j < 4; ++j) { const f32x4 v = xr[64 * j]; v2u w; w.x = pk2(v.x, v.y); w.y = pk2(v.z, v.w); bo[64 * j] = w; s += (v.x * v.x + v.y * v.y) + (v.z * v.z + v.w * v.w); }
                s = wave_sum(s);
                if (lane < 16) SSF[(size_t)m * 16 + lane] = (lane == 0) ? s : 0.f;
            }
            if (bx == 0) for (int i = tid; i < XCD_BAR_WORDS; i += NTHREADS) ((unsigned*)(ws + WS_BAR))[i] = 0u;
        } else if (ph == NPHASE - 1) {
            for (int m = gw; m < M_TOK; m += NGW) final_row(XN + (size_t)m * DMODEL, SSF + (size_t)m * 16, AIN(20), X + (size_t)m * DMODEL, lane);
        }
        if (sub == 6) ret_scan(ST, AIN(9) + l * 4, AIN(10) + l * 4, G, bx, tid);
        if (ph == 0 || (sub == 6 && l + 1 < DEPTH)) {
            const int cl = (ph == 0) ? 0 : l + 1;
            bf16_t* const WD = (bf16_t*)(ws + ((cl & 1) ? WS_WB1 : WS_WB));
            LAS float* scr = (LAS float*)(lds + wave * 16384);
            constexpr int I0 = 16 * 176, I1 = 44 * 32, I2 = 16 * 72, I3 = 16 * 64, I4 = 8 * 32, I5 = 8 * 32, I6 = 16 * 32, I7 = 16 * 176, I8 = 44 * 32;
            constexpr int NITEMS = I0 + I1 + I2 + I3 + I4 + I5 + I6 + I7 + I8;
            const int cw0 = (ph == 0) ? gw : bx * (NWAVES - 1) + wave - 1, cnw = (ph == 0) ? NGW : G * (NWAVES - 1);
            for (int it = (ph != 0 && wave == 0) ? NITEMS : cw0; it < NITEMS; it += cnw) {
                int r = it;
                if (r < I0) { transpose_item(AIN(3) + (size_t)cl * 1024 * 5632, AIN(2) + cl * 1024, 1024, 5632, WD + OW13A, 1, scr, r, lane); continue; } r -= I0;
                if (r < I1) { transpose_item(AIN(4) + (size_t)cl * 2816 * 1024, nullptr, 2816, 1024, WD + OW2A, 0, scr, r, lane); continue; } r -= I1;
                if (r < I2) { transpose_item(AIN(6) + (size_t)cl * 1024 * 2304, AIN(5) + cl * 1024, 1024, 2304, WD + OWIN, 2, scr, r, lane); continue; } r -= I2;
                if (r < I3) { transpose_item(AIN(14) + (size_t)cl * 1024 * 2048, AIN(5) + cl * 1024, 1024, 2048, WD + OWG, 3, scr, r, lane); continue; } r -= I3;
                if (r < I4) { transpose_item(AIN(12) + (size_t)cl * 512 * 1024, nullptr, 512, 1024, WD + OWBA, 0, scr, r, lane); continue; } r -= I4;
                if (r < I5) { transpose_item(AIN(13) + (size_t)cl * 512 * 1024, nullptr, 512, 1024, WD + OWBR, 0, scr, r, lane); continue; } r -= I5;
                if (r < I6) { transpose_item(AIN(16) + (size_t)cl * 1024 * 1024, nullptr, 1024, 1024, WD + OWO, 0, scr, r, lane); continue; } r -= I6;
                if (r < I7) { transpose_item(AIN(18) + (size_t)cl * 1024 * 5632, AIN(17) + cl * 1024, 1024, 5632, WD + OW13B, 1, scr, r, lane); continue; } r -= I7;
                transpose_item(AIN(19) + (size_t)cl * 2816 * 1024, nullptr, 2816, 1024, WD + OW2B, 0, scr, r, lane);
            }
            asm volatile("s_waitcnt vmcnt(0) lgkmcnt(0)" ::: "memory"); __syncthreads();
        }
        if (is_layer) {
            if (sub == 5) {
                long rowbase; int T, h, qb;
#ifndef NO_ATTN
                for (int i = 0; attn_unit_of(G, bx, i, rowbase, T, h, qb); ++i)
                    attn_body::attn_unit<8>(rowbase, T, h, qb, (const attn_body::bf16*)Qb, (const attn_body::bf16*)Kb, (const attn_body::bf16*)Vb, (attn_body::bf16*)(dry ? Tb : Qb), (char*)lds_raw);
#endif
                __syncthreads();
                ret_local_states(lds, RK, RV, ST, AIN(9) + l * 4, AIN(10) + l * 4, G, bx, tid);
            }
            if (sub == 7) ret_outputs(lds, RQ, RK, RV, RG, ST, AIN(9) + l * 4, AIN(10) + l * 4, AIN(11) + l * 512, G, bx, tid);
            if (sub == 6 || sub == 7) { asm volatile("s_waitcnt vmcnt(0) lgkmcnt(0)" ::: "memory"); __syncthreads(); }
#ifndef NO_G1
            if (sub == 1 || sub == 11) {
                pg8::Gemm g{XN, WB + (sub == 1 ? OW13A : OW13B), M_TOK, 2 * DFF, DMODEL}; pg8::StaticOrder S; S.init(M_TOK, 2 * DFF, G, bx);
                pg8::EpiSwiglu E{HB, DFF, SSF};
                pg8::gemm_phase<pg8::EpiSwiglu, pg8::StaticOrder, true, true>(lds, g, S, E);
            }
#endif
#ifndef NO_G2
            if (sub == 2 || sub == 12 || sub == 9) {
                pg8::Gemm g{sub == 9 ? Tb : HB, WB + (sub == 2 ? OW2A : sub == 12 ? OW2B : OWO), M_TOK, DMODEL, sub == 9 ? DMODEL : DFF}; pg8::StaticOrder S; S.init(M_TOK, DMODEL, G, bx);
                const bool first = (l == 0 && sub == 2);
                pg8::EpiResid E{XN, first ? AIN(0) : (const float*)nullptr, first ? AIN(1) - (size_t)PROMPT_ROWS * DMODEL : (const float*)nullptr, SSF, sub == 9 ? 1.0f : 0.5f};
                pg8::gemm_phase<pg8::EpiResid, pg8::StaticOrder, false, true>(lds, g, S, E);
            }
#endif
#ifndef NO_G3
            if (sub == 4) {
                pg8::Gemm g{XN, WB + OWIN, M_TOK, NPROJ, DMODEL}; pg8::StaticOrder S; S.init(M_TOK, NPROJ, G, bx);
                pg8::EpiInProj E{(bf16_t*)(ws + WS_B), AIN(7) + l * 64, AIN(8) + l * 64, SSF, ATT_C2};
                pg8::gemm_phase<pg8::EpiInProj, pg8::StaticOrder, true, true>(lds, g, S, E);
            }
#endif
#ifndef NO_G4
            if (sub == 6 || sub == 8 || sub == 13) {
                const int mode = (sub == 6) ? 0 : (sub == 8) ? 5 : 4;
                const bf16_t* A = (mode == 0) ? Qb : (mode == 5) ? RG : XN;
                const bf16_t* Bt = WB + ((mode == 0) ? OWBA : (mode == 5) ? OWBR : OWG);
                const int Ng = (mode == 4) ? 2 * DMODEL : DMODEL;
                pg8::Gemm g{A, Bt, M_TOK, Ng, (mode == 4) ? DMODEL : 512}; pg8::StaticOrder S; S.init(M_TOK, Ng, G, bx);
                pg8::EpiMix E{Tb, Ub, AIN(15) + (size_t)l * 2048, SSF, mode};
                if (mode == 4) pg8::gemm_phase<pg8::EpiMix, pg8::StaticOrder, true, true>(lds, g, S, E);
                else pg8::gemm_phase<pg8::EpiMix, pg8::StaticOrder, false, true>(lds, g, S, E);
            }
#endif
        }
#ifdef DUP_MASK
        if (step + 1 < 2 * ph_hi) grid.sync();
#else
        if (ph + 1 < ph_hi) {
            unsigned* const barw = (unsigned*)(ka->ws + WS_BAR);
            if (ph == 0) { grid.sync();
                if (threadIdx.x == 0) (void)xb_add(&barw[XB_XCNT(xb_xcc_id())], 1u); }
            else { XcdBarrier b; b.bar = barw; b.x = xb_xcc_id(); b.st = (volatile LAS unsigned*)((LAS unsigned char*)lds_raw + LDS_MISC + 32); xcd_barrier(b); }
        }
#endif
    }
#ifdef EXTRA_SYNCS
    for (int i = 0; i < EXTRA_SYNCS; ++i) grid.sync();
#endif
}

extern "C" void kernel_launch(void* const* d_in, const int* in_sizes, int n_in, void* d_out, int out_size, void* d_ws, size_t ws_size, hipStream_t stream) {
    static int grid = 0;
    if (grid == 0) {
        if (n_in != 21 || out_size != M_TOK * DMODEL || ws_size < WS_END) { fprintf(stderr, "kernel_launch: unexpected shapes: n_in %d out %d ws %zu (need %zu)\n", n_in, out_size, ws_size, (size_t)WS_END); grid = -1; return; }
        int dev = 0, cus = 0, per_cu = 0;
        if (hipGetDevice(&dev) != hipSuccess || hipDeviceGetAttribute(&cus, hipDeviceAttributeMultiprocessorCount, dev) != hipSuccess) { grid = -1; return; }
        if (hipFuncSetAttribute((const void*)fwd_kernel, hipFuncAttributeMaxDynamicSharedMemorySize, LDS_BYTES) != hipSuccess) { fprintf(stderr, "kernel_launch: hipFuncSetAttribute failed\n"); grid = -1; return; }
        if (hipOccupancyMaxActiveBlocksPerMultiprocessor(&per_cu, (const void*)fwd_kernel, NTHREADS, LDS_BYTES) != hipSuccess || per_cu < 1) { fprintf(stderr, "kernel_launch: occupancy query says %d\n", per_cu); per_cu = 1; }
        (void)hipGetLastError();
        grid = cus * per_cu;
    }
    if (grid < 0) return;
    Args a{};
    for (int i = 0; i < 21; ++i) a.in[i] = (const float*)d_in[i];
    a.out = (float*)d_out; a.ws = (unsigned char*)d_ws;
#if MULTI_LAUNCH
    for (int ph = 0; ph < NPHASE; ++ph) {
        a.ph_lo = ph; a.ph_hi = ph + 1;
        hipLaunchKernelGGL(fwd_kernel, dim3(grid), dim3(NTHREADS), LDS_BYTES, stream, a);
    }
#else
    a.ph_lo = 0; a.ph_hi = NPHASE;
    void* kargs[] = {&a};
    hipError_t e = hipLaunchCooperativeKernel((const void*)fwd_kernel, dim3(grid), dim3(NTHREADS), kargs, LDS_BYTES, stream);
    if (e != hipSuccess) fprintf(stderr, "kernel_launch: cooperative launch failed: %s (grid %d)\n", hipGetErrorString(e), grid);
#endif
}
```

```cpp
#include <hip/hip_runtime.h>
#include <hip/hip_cooperative_groups.h>
#include <cstdio>
#include <cstdint>
namespace cg = cooperative_groups;
#define MULTI_LAUNCH 0
namespace pg8 {
#define PG8_LAS __attribute__((address_space(3)))
typedef unsigned short bf16_t;
typedef short bf16x8 __attribute__((ext_vector_type(8)));
typedef float f32x4 __attribute__((ext_vector_type(4)));
typedef unsigned u32x4 __attribute__((ext_vector_type(4)));
constexpr int BM = 256, BK = 64, HALF = 128, HTB = HALF * BK * 2  , STAGE_BYTES = 8 * HTB, NXCD = 8, WGM = 8;

__host__ __device__ __forceinline__ int lds_byte(int r, int c) { const int st = (r >> 4) * 2 + (c >> 5), rr = r & 15, cc = c & 31, ob = rr * 64 + cc * 2; return st * 1024 + (ob ^ (((ob >> 9) & 1) << 5)); }
__host__ __device__ __forceinline__ void stage_rc(int b, int& R, int& C) { const int st = b / 1024, sb = b % 1024, swz = sb ^ (((sb >> 9) & 1) << 5); R = (st >> 1) * 16 + swz / 64; C = (st & 1) * 32 + (swz % 64) / 2; }
__host__ __device__ __forceinline__ int perm32(int rho) { const int n = rho >> 4, i = rho & 15; return 8 * (i >> 2) + 4 * n + (i & 3); }

struct Unit { int pm, pn; };
struct Gemm { const bf16_t* A; const bf16_t* Bt; int M, N, K; };

struct StaticOrder {
    int nM, nN, nwg, G, c;
    __host__ __device__ void init(int M, int N, int G_, int c_) { nM = M / BM; nN = N / BM; nwg = nM * nN; G = G_; c = c_; }
    __host__ __device__ bool next(int i, Unit& u) const {
        const long L = (long)i * G + c; if (L >= nwg) return false;
        int wgid = (int)L; { const int q = nwg / NXCD, r = nwg % NXCD, xcd = wgid % NXCD, off = wgid / NXCD; wgid = (xcd < r ? xcd * (q + 1) : r * (q + 1) + (xcd - r) * q) + off; }
        const int nig = WGM * nN, gid = wgid / nig, fm = gid * WGM, gsz = (nM - fm) < WGM ? (nM - fm) : WGM;
        u.pm = fm + ((wgid % nig) % gsz); u.pn = (wgid % nig) / gsz; return true;
    }
    __device__ __forceinline__ void a_ready(const Unit&) const {}
    __device__ __forceinline__ void done(const Unit&) const {}
};

typedef float f32x2 __attribute__((ext_vector_type(2)));
typedef __bf16 bf16x2_cv __attribute__((ext_vector_type(2)));
__device__ __forceinline__ unsigned cvt_pk_bf16(float lo, float hi) { f32x2 v = {lo, hi}; bf16x2_cv b = __builtin_convertvector(v, bf16x2_cv); return __builtin_bit_cast(unsigned, b); }
typedef _Float16 f16x2_cv __attribute__((ext_vector_type(2)));
typedef _Float16 f16x8_cv __attribute__((ext_vector_type(8)));
__device__ __forceinline__ unsigned cvt_pk_f16(float lo, float hi) { f32x2 v = {lo, hi}; f16x2_cv h = __builtin_convertvector(v, f16x2_cv); return __builtin_bit_cast(unsigned, h); }
__device__ __forceinline__ f32x2 cvt_f16_pair(unsigned w) { return __builtin_convertvector(__builtin_bit_cast(f16x2_cv, w), f32x2); }
template <bool F16> __device__ __forceinline__ f32x4 mma16(bf16x8 a, bf16x8 b, f32x4 c) {
    if constexpr (F16) return __builtin_amdgcn_mfma_f32_16x16x32_f16(__builtin_bit_cast(f16x8_cv, a), __builtin_bit_cast(f16x8_cv, b), c, 0, 0, 0);
    else return __builtin_amdgcn_mfma_f32_16x16x32_bf16(a, b, c, 0, 0, 0);
}
typedef unsigned u32x2 __attribute__((ext_vector_type(2)));
__device__ __forceinline__ int opaque_tid() { int t = threadIdx.x; asm volatile("" : "+v"(t)); return t; }
__device__ __forceinline__ float bf_lo(unsigned w) { return __uint_as_float(w << 16); }
__device__ __forceinline__ float bf_hi(unsigned w) { return __uint_as_float(w & 0xffff0000u); }
__device__ __forceinline__ float sigmoid_f(float v) { return __builtin_amdgcn_rcpf(1.f + __builtin_amdgcn_exp2f(-1.4426950408889634f * v)); }
__device__ __forceinline__ float silu_f(float v) { return v * sigmoid_f(v); }
__device__ __forceinline__ void rows_rstd(const float* SS, int row0, int fq, float (&rstd)[8]) {
    f32x4 pr[8];
#pragma unroll
    for (int k = 0; k < 8; ++k) pr[k] = *(const f32x4*)(SS + (size_t)(row0 + (k >> 2) * HALF + (k & 3) * 16) * 16 + 4 * fq);
#pragma unroll
    for (int k = 0; k < 8; ++k) { float s = (pr[k][0] + pr[k][1]) + (pr[k][2] + pr[k][3]); s += __shfl_xor(s, 16); s += __shfl_xor(s, 32); rstd[k] = __builtin_amdgcn_rsqf(s * (1.0f / 1024.0f) + 1e-6f); }
}

__device__ __forceinline__ void unpack8(const u32x4 w, f32x4& lo, f32x4& hi) { lo[0] = bf_lo(w.x); lo[1] = bf_hi(w.x); lo[2] = bf_lo(w.y); lo[3] = bf_hi(w.y); hi[0] = bf_lo(w.z); hi[1] = bf_hi(w.z); hi[2] = bf_lo(w.w); hi[3] = bf_hi(w.w); }
__device__ __forceinline__ u32x4 pack8(const f32x4 a, const f32x4 b) { u32x4 w; w.x = cvt_pk_bf16(a[0], a[1]); w.y = cvt_pk_bf16(a[2], a[3]); w.z = cvt_pk_bf16(b[0], b[1]); w.w = cvt_pk_bf16(b[2], b[3]); return w; }
struct EpiSwiglu {
    static constexpr bool PERM = true, AFTER_DRAIN = false;
    bf16_t* H; int ldh; const float* SS;
    __device__ __forceinline__ void operator()(const f32x4 (&acc)[2][2][4][2], const Unit& u, int wr, int wc, int fr, int fq) const {
        const int row0 = u.pm * BM + wr * 64 + fr, col0 = u.pn * HALF + wc * 32 + 8 * fq;
        float rstd[8]; rows_rstd(SS, row0, fq, rstd);
#pragma unroll
        for (int ai = 0; ai < 2; ++ai)
#pragma unroll
            for (int m = 0; m < 4; ++m) {
                bf16_t* p = H + (size_t)(row0 + ai * HALF + m * 16) * ldh + col0;
                const float rs = rstd[ai * 4 + m], nrs = -1.4426950408889634f * rs, rs2 = rs * rs;
                const f32x4 a0 = acc[ai][0][m][0], a1 = acc[ai][0][m][1], b0 = acc[ai][1][m][0], b1 = acc[ai][1][m][1];
                const f32x4 t0 = a0 * nrs, t1 = a1 * nrs;
                f32x4 e0, e1;
                e0[0] = __builtin_amdgcn_exp2f(t0[0]); e0[1] = __builtin_amdgcn_exp2f(t0[1]); e0[2] = __builtin_amdgcn_exp2f(t0[2]); e0[3] = __builtin_amdgcn_exp2f(t0[3]);
                e1[0] = __builtin_amdgcn_exp2f(t1[0]); e1[1] = __builtin_amdgcn_exp2f(t1[1]); e1[2] = __builtin_amdgcn_exp2f(t1[2]); e1[3] = __builtin_amdgcn_exp2f(t1[3]);
                const f32x4 d0 = e0 + 1.0f, d1 = e1 + 1.0f, ab0 = a0 * b0, ab1 = a1 * b1;
                f32x4 r0, r1;
                r0[0] = __builtin_amdgcn_rcpf(d0[0]); r0[1] = __builtin_amdgcn_rcpf(d0[1]); r0[2] = __builtin_amdgcn_rcpf(d0[2]); r0[3] = __builtin_amdgcn_rcpf(d0[3]);
                r1[0] = __builtin_amdgcn_rcpf(d1[0]); r1[1] = __builtin_amdgcn_rcpf(d1[1]); r1[2] = __builtin_amdgcn_rcpf(d1[2]); r1[3] = __builtin_amdgcn_rcpf(d1[3]);
                const f32x4 h0 = ab0 * (r0 * rs2), h1 = ab1 * (r1 * rs2);
                u32x4 w;
                w.x = cvt_pk_bf16(h0[0], h0[1]); w.y = cvt_pk_bf16(h0[2], h0[3]); w.z = cvt_pk_bf16(h1[0], h1[1]); w.w = cvt_pk_bf16(h1[2], h1[3]);
                *(u32x4*)p = w;
            }
    }
};
struct EpiResid {
    static constexpr bool PERM = true, AFTER_DRAIN = false;
    bf16_t* XH; const float* S0; const float* S1; float* SSo; float s;
    __device__ __forceinline__ void operator()(const f32x4 (&acc)[2][2][4][2], const Unit& u, int wr, int wc, int fr, int fq) const {
        const int row0 = u.pm * BM + wr * 64 + fr, col0 = u.pn * BM + wc * 32 + 8 * fq;
        const bool first = (S0 != nullptr);
        const float* src = (u.pm < 64) ? S0 : S1;
        if (first) {
#pragma unroll
            for (int ai = 0; ai < 2; ++ai) {
                f32x4 raw[4][2][2];
#pragma unroll
                for (int m = 0; m < 4; ++m)
#pragma unroll
                    for (int bj = 0; bj < 2; ++bj) { const float* p = src + (size_t)(row0 + ai * HALF + m * 16) * 1024 + col0 + bj * HALF; raw[m][bj][0] = *(const f32x4*)p; raw[m][bj][1] = *(const f32x4*)(p + 4); }
                asm volatile("" ::: "memory");
#pragma unroll
                for (int m = 0; m < 4; ++m) {
                    float ss = 0.f;
#pragma unroll
                    for (int bj = 0; bj < 2; ++bj) {
                        const f32x4 o0 = raw[m][bj][0] + acc[ai][bj][m][0] * s, o1 = raw[m][bj][1] + acc[ai][bj][m][1] * s;
                        const f32x4 q = o0 * o0 + o1 * o1; ss += (q[0] + q[1]) + (q[2] + q[3]);
                        *(u32x4*)(XH + (size_t)(row0 + ai * HALF + m * 16) * 1024 + col0 + bj * HALF) = pack8(o0, o1);
                    }
                    ss += __shfl_xor(ss, 16); ss += __shfl_xor(ss, 32);
                    if (fq == 0) SSo[(size_t)(row0 + ai * HALF + m * 16) * 16 + u.pn * 4 + wc] = ss;
                }
                asm volatile("" ::: "memory");
            }
        } else {
#pragma unroll
            for (int ai = 0; ai < 2; ++ai) {
                u32x4 raw[4][2];
#pragma unroll
                for (int m = 0; m < 4; ++m)
#pragma unroll
                    for (int bj = 0; bj < 2; ++bj) raw[m][bj] = *(const u32x4*)(XH + (size_t)(row0 + ai * HALF + m * 16) * 1024 + col0 + bj * HALF);
                asm volatile("" ::: "memory");
#pragma unroll
                for (int m = 0; m < 4; ++m) {
                    float ss = 0.f;
#pragma unroll
                    for (int bj = 0; bj < 2; ++bj) {
                        f32x4 x0, x1; unpack8(raw[m][bj], x0, x1);
                        const f32x4 o0 = x0 + acc[ai][bj][m][0] * s, o1 = x1 + acc[ai][bj][m][1] * s;
                        const f32x4 q = o0 * o0 + o1 * o1; ss += (q[0] + q[1]) + (q[2] + q[3]);
                        *(u32x4*)(XH + (size_t)(row0 + ai * HALF + m * 16) * 1024 + col0 + bj * HALF) = pack8(o0, o1);
                    }
                    ss += __shfl_xor(ss, 16); ss += __shfl_xor(ss, 32);
                    if (fq == 0) SSo[(size_t)(row0 + ai * HALF + m * 16) * 16 + u.pn * 4 + wc] = ss;
                }
                asm volatile("" ::: "memory");
            }
        }
    }
};
__device__ __forceinline__ void sigmoid8(f32x4& v0, f32x4& v1) {
    const f32x4 t0 = v0 * -1.4426950408889634f, t1 = v1 * -1.4426950408889634f; f32x4 e0, e1;
    e0[0] = __builtin_amdgcn_exp2f(t0[0]); e0[1] = __builtin_amdgcn_exp2f(t0[1]); e0[2] = __builtin_amdgcn_exp2f(t0[2]); e0[3] = __builtin_amdgcn_exp2f(t0[3]);
    e1[0] = __builtin_amdgcn_exp2f(t1[0]); e1[1] = __builtin_amdgcn_exp2f(t1[1]); e1[2] = __builtin_amdgcn_exp2f(t1[2]); e1[3] = __builtin_amdgcn_exp2f(t1[3]);
    const f32x4 d0 = e0 + 1.0f, d1 = e1 + 1.0f;
    v0[0] = __builtin_amdgcn_rcpf(d0[0]); v0[1] = __builtin_amdgcn_rcpf(d0[1]); v0[2] = __builtin_amdgcn_rcpf(d0[2]); v0[3] = __builtin_amdgcn_rcpf(d0[3]);
    v1[0] = __builtin_amdgcn_rcpf(d1[0]); v1[1] = __builtin_amdgcn_rcpf(d1[1]); v1[2] = __builtin_amdgcn_rcpf(d1[2]); v1[3] = __builtin_amdgcn_rcpf(d1[3]);
}
struct EpiMix {
    static constexpr bool PERM = true, AFTER_DRAIN = false;
    bf16_t* T; bf16_t* U; const float* bias; const float* SS; int mode;
    template <int MODE> __device__ __forceinline__ void run(const f32x4 (&acc)[2][2][4][2], const Unit& u, int wr, int wc, int fr, int fq) const {
        const int row0 = u.pm * BM + wr * 64 + fr, col0 = u.pn * BM + wc * 32 + 8 * fq;
        float rstd[8];
        if (MODE == 1 || MODE == 2) rows_rstd(SS, row0, fq, rstd);
#pragma unroll
        for (int bj = 0; bj < 2; ++bj) {
            f32x4 bv0 = (f32x4){0.f, 0.f, 0.f, 0.f}, bv1 = bv0;
            if (MODE == 1 || MODE == 2) { bv0 = *(const f32x4*)(bias + col0 + bj * HALF); bv1 = *(const f32x4*)(bias + col0 + bj * HALF + 4); }
#pragma unroll
            for (int ai = 0; ai < 2; ++ai) {
                u32x4 tw[4], uw[4];
                if (MODE == 1 || MODE == 3) {
#pragma unroll
                    for (int m = 0; m < 4; ++m) tw[m] = *(const u32x4*)(T + (size_t)(row0 + ai * HALF + m * 16) * 1024 + col0 + bj * HALF); }
                if (MODE == 3) {
#pragma unroll
                    for (int m = 0; m < 4; ++m) uw[m] = *(const u32x4*)(U + (size_t)(row0 + ai * HALF + m * 16) * 1024 + col0 + bj * HALF); }
                asm volatile("" ::: "memory");
#pragma unroll
                for (int m = 0; m < 4; ++m) {
                    const size_t idx = (size_t)(row0 + ai * HALF + m * 16) * 1024 + col0 + bj * HALF;
                    f32x4 v0 = acc[ai][bj][m][0], v1 = acc[ai][bj][m][1];
                    if (MODE == 1 || MODE == 2) { const float rs = rstd[ai * 4 + m]; v0 = v0 * rs + bv0; v1 = v1 * rs + bv1; sigmoid8(v0, v1); }
                    if (MODE == 1) { f32x4 t0, t1; unpack8(tw[m], t0, t1); v0 = v0 * t0; v1 = v1 * t1; }
                    if (MODE == 3) { f32x4 t0, t1, g0, g1; unpack8(tw[m], t0, t1); unpack8(uw[m], g0, g1); v0 = t0 + g0 * v0; v1 = t1 + g1 * v1; }
                    u32x4 w; w.x = cvt_pk_bf16(v0[0], v0[1]); w.y = cvt_pk_bf16(v0[2], v0[3]); w.z = cvt_pk_bf16(v1[0], v1[1]); w.w = cvt_pk_bf16(v1[2], v1[3]);
                    *(u32x4*)(((MODE == 2 || MODE == 5) ? U : T) + idx) = w;
                }
                asm volatile("" ::: "memory");
            }
        }
    }
    __device__ __forceinline__ void run4(const f32x4 (&acc)[2][2][4][2], const Unit& u, int wr, int wc, int fr, int fq) const {
        const int row0 = u.pm * BM + wr * 64 + fr, mcol0 = u.pn * HALF + wc * 32 + 8 * fq;
        float rstd[8]; rows_rstd(SS, row0, fq, rstd);
        const f32x4 ba0 = *(const f32x4*)(bias + mcol0), ba1 = *(const f32x4*)(bias + mcol0 + 4), br0 = *(const f32x4*)(bias + 1024 + mcol0), br1 = *(const f32x4*)(bias + 1024 + mcol0 + 4);
#pragma unroll
        for (int ai = 0; ai < 2; ++ai) {
            u32x4 tw[4], uw[4];
#pragma unroll
            for (int m = 0; m < 4; ++m) { const size_t idx = (size_t)(row0 + ai * HALF + m * 16) * 1024 + mcol0; tw[m] = *(const u32x4*)(T + idx); uw[m] = *(const u32x4*)(U + idx); }
            asm volatile("" ::: "memory");
#pragma unroll
            for (int m = 0; m < 4; ++m) {
                const size_t idx = (size_t)(row0 + ai * HALF + m * 16) * 1024 + mcol0;
                const float rs = rstd[ai * 4 + m];
                f32x4 o0, o1;
                { f32x4 a0 = acc[ai][0][m][0] * rs + ba0, a1 = acc[ai][0][m][1] * rs + ba1; sigmoid8(a0, a1); f32x4 t0, t1; unpack8(tw[m], t0, t1); o0 = a0 * t0; o1 = a1 * t1; }
                asm volatile("" : "+v"(o0), "+v"(o1));
                { f32x4 r0 = acc[ai][1][m][0] * rs + br0, r1 = acc[ai][1][m][1] * rs + br1; sigmoid8(r0, r1); f32x4 g0, g1; unpack8(uw[m], g0, g1); o0 = o0 + r0 * g0; o1 = o1 + r1 * g1; }
                *(u32x4*)(T + idx) = pack8(o0, o1);
            }
            asm volatile("" ::: "memory");
        }
    }
    __device__ __forceinline__ void operator()(const f32x4 (&acc)[2][2][4][2], const Unit& u, int wr, int wc, int fr, int fq) const {
        if (mode == 0) run<0>(acc, u, wr, wc, fr, fq);
        else if (mode == 5) run<5>(acc, u, wr, wc, fr, fq);
        else run4(acc, u, wr, wc, fr, fq);
    }
};
struct EpiInProj {
    static constexpr bool PERM = true, AFTER_DRAIN = false;
    static constexpr size_t EMI = 524288;
    static constexpr size_t EQ = 0, EK = 48 * EMI, EV = 60 * EMI, ERQ = 72 * EMI, ERK = 96 * EMI, ERV = 120 * EMI, ERG = 168 * EMI;
    bf16_t* base; const float *qn, *kn, *SS; float qscale;
    __device__ __forceinline__ void operator()(const f32x4 (&acc)[2][2][4][2], const Unit& u, int wr, int wc, int fr, int fq) const {
        const int pn = u.pn, row0 = u.pm * BM + wr * 64 + fr;
        const bool isq = pn <= 1, isk = (pn == 2 && wc < 2), isv = (pn == 2 && wc >= 2);
        const bool do_norm = isq || isk, do_rope = isq || isk || pn == 3 || pn == 4;
        float g_lo[8], g_hi[8];
#pragma unroll
        for (int e = 0; e < 8; ++e) { g_lo[e] = 1.f; g_hi[e] = 1.f; }
        if (do_norm) { const float* g = isq ? qn : kn;
#pragma unroll
            for (int e = 0; e < 8; ++e) { g_lo[e] = g[8 * fq + e]; g_hi[e] = g[32 + 8 * fq + e]; } }
        const float post = isq ? qscale : (pn == 4 ? 0.125f : 1.f);
        size_t eo; int ld, cb;
        if (isq) { eo = EQ; ld = 512; cb = (4 * pn + wc) * 64; }
        else if (isk) { eo = EK; ld = 128; cb = wc * 64; }
        else if (isv) { eo = EV; ld = 128; cb = (wc - 2) * 64; }
        else if (pn == 3) { eo = ERQ; ld = 256; cb = wc * 64; }
        else if (pn == 4) { eo = ERK; ld = 256; cb = wc * 64; }
        else if (pn <= 6) { eo = ERV; ld = 512; cb = (pn - 5) * 256 + wc * 64; }
        else { eo = ERG; ld = 512; cb = (pn - 7) * 256 + wc * 64; }
        bf16_t* dst = base + eo;
        float rstd[8]; rows_rstd(SS, row0, fq, rstd);
        f32x4 gl0, gl1, gh0, gh1;
#pragma unroll
        for (int e = 0; e < 4; ++e) { gl0[e] = g_lo[e]; gl1[e] = g_lo[4 + e]; gh0[e] = g_hi[e]; gh1[e] = g_hi[4 + e]; }
#pragma unroll
        for (int ai = 0; ai < 2; ++ai)
#pragma unroll
            for (int m = 0; m < 4; ++m) {
                const int row = row0 + ai * HALF + m * 16;
                const float rs = rstd[ai * 4 + m];
                f32x4 lo0 = acc[ai][0][m][0] * rs, lo1 = acc[ai][0][m][1] * rs, hi0 = acc[ai][1][m][0] * rs, hi1 = acc[ai][1][m][1] * rs;
                if (do_norm) {
                    const f32x4 q = lo0 * lo0 + lo1 * lo1 + hi0 * hi0 + hi1 * hi1;
                    float ss = (q[0] + q[1]) + (q[2] + q[3]);
                    ss += __shfl_xor(ss, 16); ss += __shfl_xor(ss, 32);
                    const float hr = __builtin_amdgcn_rsqf(ss * (1.0f / 64.0f) + 1e-6f);
                    lo0 = lo0 * (gl0 * hr); lo1 = lo1 * (gl1 * hr); hi0 = hi0 * (gh0 * hr); hi1 = hi1 * (gh1 * hr);
                }
                if (do_rope) {
                    const int t = row < 16384 ? row : (row & 4095);
                    const float pf = (float)((fq < 2) ? (t >> 6) : (t & 63));
                    int fqo = fq & 1; asm volatile("" : "+v"(fqo));
                    const float fb = (float)(8 * fqo) * (-13.287712379549449f / 16.0f);
                    f32x4 x0, x1;
                    x0[0] = __builtin_amdgcn_exp2f(fb); x0[1] = __builtin_amdgcn_exp2f(fb - 1.0f * (13.287712379549449f / 16.0f)); x0[2] = __builtin_amdgcn_exp2f(fb - 2.0f * (13.287712379549449f / 16.0f)); x0[3] = __builtin_amdgcn_exp2f(fb - 3.0f * (13.287712379549449f / 16.0f));
                    x1[0] = __builtin_amdgcn_exp2f(fb - 4.0f * (13.287712379549449f / 16.0f)); x1[1] = __builtin_amdgcn_exp2f(fb - 5.0f * (13.287712379549449f / 16.0f)); x1[2] = __builtin_amdgcn_exp2f(fb - 6.0f * (13.287712379549449f / 16.0f)); x1[3] = __builtin_amdgcn_exp2f(fb - 7.0f * (13.287712379549449f / 16.0f));
                    x0 = x0 * (pf * 0.15915494309189535f); x1 = x1 * (pf * 0.15915494309189535f);
                    f32x4 r0, r1;
                    r0[0] = __builtin_rintf(x0[0]); r0[1] = __builtin_rintf(x0[1]); r0[2] = __builtin_rintf(x0[2]); r0[3] = __builtin_rintf(x0[3]);
                    r1[0] = __builtin_rintf(x1[0]); r1[1] = __builtin_rintf(x1[1]); r1[2] = __builtin_rintf(x1[2]); r1[3] = __builtin_rintf(x1[3]);
                    x0 = x0 - r0; x1 = x1 - r1;
                    f32x4 c0, c1, s0, s1;
                    c0[0] = __builtin_amdgcn_cosf(x0[0]); c0[1] = __builtin_amdgcn_cosf(x0[1]); c0[2] = __builtin_amdgcn_cosf(x0[2]); c0[3] = __builtin_amdgcn_cosf(x0[3]);
                    c1[0] = __builtin_amdgcn_cosf(x1[0]); c1[1] = __builtin_amdgcn_cosf(x1[1]); c1[2] = __builtin_amdgcn_cosf(x1[2]); c1[3] = __builtin_amdgcn_cosf(x1[3]);
                    s0[0] = __builtin_amdgcn_sinf(x0[0]); s0[1] = __builtin_amdgcn_sinf(x0[1]); s0[2] = __builtin_amdgcn_sinf(x0[2]); s0[3] = __builtin_amdgcn_sinf(x0[3]);
                    s1[0] = __builtin_amdgcn_sinf(x1[0]); s1[1] = __builtin_amdgcn_sinf(x1[1]); s1[2] = __builtin_amdgcn_sinf(x1[2]); s1[3] = __builtin_amdgcn_sinf(x1[3]);
                    const f32x4 a0 = (lo0 * c0 - hi0 * s0) * post, a1 = (lo1 * c1 - hi1 * s1) * post, b0 = (lo0 * s0 + hi0 * c0) * post, b1 = (lo1 * s1 + hi1 * c1) * post;
                    lo0 = a0; lo1 = a1; hi0 = b0; hi1 = b1;
                }
                bf16_t* p = dst + (size_t)row * ld + cb + 8 * fq;
                u32x4 w; w.x = cvt_pk_bf16(lo0[0], lo0[1]); w.y = cvt_pk_bf16(lo0[2], lo0[3]); w.z = cvt_pk_bf16(lo1[0], lo1[1]); w.w = cvt_pk_bf16(lo1[2], lo1[3]);
                *(u32x4*)p = w;
                w.x = cvt_pk_bf16(hi0[0], hi0[1]); w.y = cvt_pk_bf16(hi0[2], hi0[3]); w.z = cvt_pk_bf16(hi1[0], hi1[1]); w.w = cvt_pk_bf16(hi1[2], hi1[3]);
                *(u32x4*)(p + 32) = w;
                asm volatile("" ::: "memory");
            }
    }
};
template <class Epi, class Sched, bool ALIGN_EPI = false, bool SP2 = false>
__device__ __forceinline__ void gemm_phase(PG8_LAS unsigned char* lds, const Gemm g, const Sched& S, const Epi& E) {
    const int tid = opaque_tid(), wid = __builtin_amdgcn_readfirstlane(tid >> 6), lane = tid & 63, wr = wid >> 2, wc = wid & 3, fr = lane & 15, fq = lane >> 4;
    const int K = g.K, nt = K / BK;
    unsigned voffA[2], voffB[2];
#pragma unroll
    for (int i = 0; i < 2; ++i) { int R, C; stage_rc(tid * 16 + i * 8192, R, C); const int Rb = Epi::PERM ? ((R & ~31) + perm32(R & 31)) : R;
        voffA[i] = (unsigned)(R * K + C) * 2u; voffB[i] = (unsigned)(Rb * K + C) * 2u; }
    const size_t kstep = (size_t)(BK * 2);
    const size_t hstep = (size_t)HALF * K * 2;
    const size_t tstep = 2 * hstep;
    const unsigned ldsw = (unsigned)wid * 1024u;
    const int aoff = lds_byte(wr * 64 + fr, fq * 8), boff = lds_byte(wc * 32 + fr, fq * 8);
#define PG8_SA(b, h) (((b) * 2 + (h)) * HTB)
#define PG8_SB(b, h) ((4 + (b) * 2 + (h)) * HTB)
#define PG8_STAGE(bufoff, gbase, voff) do { _Pragma("unroll") for (int _i = 0; _i < 2; ++_i) \
        __builtin_amdgcn_global_load_lds((const unsigned*)((const char*)(gbase) + (voff)[_i]), (PG8_LAS unsigned*)(lds + (bufoff) + ldsw + _i * 8192), 16, 0, 0); } while (0)
#define PG8_LDA(dst, b, h) do { _Pragma("unroll") for (int m = 0; m < 4; ++m) _Pragma("unroll") for (int k = 0; k < 2; ++k) dst[m][k] = *(const PG8_LAS bf16x8*)(lds + PG8_SA(b, h) + aoff + m * 2048 + k * 1024); } while (0)
#define PG8_LDB(dst, b, h) do { _Pragma("unroll") for (int n = 0; n < 2; ++n) _Pragma("unroll") for (int k = 0; k < 2; ++k) dst[n][k] = *(const PG8_LAS bf16x8*)(lds + PG8_SB(b, h) + boff + n * 2048 + k * 1024); } while (0)
#define PG8_MMA(ai, bj, At, Bt) do { __builtin_amdgcn_s_setprio(1); _Pragma("unroll") for (int m = 0; m < 4; ++m) _Pragma("unroll") for (int n = 0; n < 2; ++n) _Pragma("unroll") for (int k = 0; k < 2; ++k) \
        acc[ai][bj][m][n] = __builtin_amdgcn_mfma_f32_16x16x32_bf16(Bt[n][k], At[m][k], acc[ai][bj][m][n], 0, 0, 0); __builtin_amdgcn_s_setprio(0); } while (0)
#define PG8_WAIT_V(n) asm volatile("s_waitcnt vmcnt(" #n ")" ::: "memory")
#define PG8_WAIT_L(n) asm volatile("s_waitcnt lgkmcnt(" #n ")" ::: "memory")
#define PG8_BAR __builtin_amdgcn_s_barrier()
#define PG8_SCHED __builtin_amdgcn_sched_barrier(0)
    Unit cur, nxt; int ui = 0;
    if (!S.next(0, cur)) return;
    f32x4 acc[2][2][4][2];
#pragma unroll
    for (int a = 0; a < 2; ++a)
#pragma unroll
        for (int b = 0; b < 2; ++b)
#pragma unroll
            for (int m = 0; m < 4; ++m)
#pragma unroll
                for (int n = 0; n < 2; ++n) acc[a][b][m][n] = (f32x4){0.f, 0.f, 0.f, 0.f};
    bf16x8 At[4][2], B0[2][2], B1[2][2];
    const char* cA = (const char*)g.A + (size_t)cur.pm * tstep; const char* cB = (const char*)g.Bt + (size_t)cur.pn * tstep;
    S.a_ready(cur);
    if constexpr (SP2) {
        PG8_STAGE(PG8_SB(0, 0), cB, voffB); PG8_STAGE(PG8_SB(0, 1), cB + hstep, voffB); PG8_STAGE(PG8_SA(0, 0), cA, voffA); PG8_STAGE(PG8_SA(0, 1), cA + hstep, voffA);
        if (wr == 1) PG8_BAR;
        PG8_WAIT_V(2); PG8_BAR;
        PG8_STAGE(PG8_SB(1, 0), cB + kstep, voffB); PG8_STAGE(PG8_SA(1, 0), cA + kstep, voffA); PG8_STAGE(PG8_SB(1, 1), cB + hstep + kstep, voffB);
        PG8_WAIT_V(6); PG8_BAR;
    } else {
        PG8_STAGE(PG8_SB(0, 0), cB, voffB); PG8_STAGE(PG8_SA(0, 0), cA, voffA); PG8_STAGE(PG8_SB(0, 1), cB + hstep, voffB); PG8_STAGE(PG8_SA(0, 1), cA + hstep, voffA);
        if (wr == 1) PG8_BAR;
        PG8_WAIT_V(4); PG8_BAR;
        PG8_STAGE(PG8_SB(1, 0), cB + kstep, voffB); PG8_STAGE(PG8_SA(1, 0), cA + kstep, voffA); PG8_STAGE(PG8_SB(1, 1), cB + hstep + kstep, voffB);
        PG8_WAIT_V(6); PG8_BAR;
    }
    for (;;) {
        const bool has_next = S.next(ui + 1, nxt);
        const char* nA = has_next ? (const char*)g.A + (size_t)nxt.pm * tstep : cA; const char* nB = has_next ? (const char*)g.Bt + (size_t)nxt.pn * tstep : cB;
        for (int t = 0; t < nt; t += 2) {
            const bool last = (t == nt - 2);
            const char* a1 = cA + (size_t)(t + 1) * kstep;
            const char* a2 = last ? nA : cA + (size_t)(t + 2) * kstep; const char* b2 = last ? nB : cB + (size_t)(t + 2) * kstep;
            const char* a3 = a2 + kstep; const char* b3 = b2 + kstep;
            if (last && has_next) S.a_ready(nxt);
            if constexpr (SP2) {
            PG8_LDB(B0, 0, 0); PG8_LDB(B1, 0, 1); PG8_SCHED; PG8_LDA(At, 0, 0); PG8_STAGE(PG8_SA(1, 1), a1 + hstep, voffA);
            PG8_WAIT_V(8); PG8_WAIT_L(0); PG8_BAR; PG8_MMA(0, 0, At, B0); PG8_MMA(0, 1, At, B1); PG8_BAR; PG8_SCHED;
            PG8_LDA(At, 0, 1); PG8_STAGE(PG8_SB(0, 0), b2, voffB); PG8_STAGE(PG8_SB(0, 1), b2 + hstep, voffB); PG8_STAGE(PG8_SA(0, 0), a2, voffA);
            PG8_WAIT_V(8); PG8_WAIT_L(0); PG8_BAR; PG8_MMA(1, 0, At, B0); PG8_MMA(1, 1, At, B1); PG8_BAR; PG8_SCHED;
            PG8_LDB(B0, 1, 0); PG8_LDB(B1, 1, 1); PG8_SCHED; PG8_LDA(At, 1, 0); PG8_STAGE(PG8_SA(0, 1), a2 + hstep, voffA);
            PG8_WAIT_V(8); PG8_WAIT_L(0); PG8_BAR; PG8_MMA(0, 0, At, B0); PG8_MMA(0, 1, At, B1); PG8_BAR; PG8_SCHED;
            PG8_LDA(At, 1, 1); PG8_STAGE(PG8_SB(1, 0), b3, voffB); PG8_STAGE(PG8_SB(1, 1), b3 + hstep, voffB); PG8_STAGE(PG8_SA(1, 0), a3, voffA);
            PG8_WAIT_V(8); PG8_WAIT_L(0); PG8_BAR; PG8_MMA(1, 0, At, B0); PG8_MMA(1, 1, At, B1); PG8_BAR; PG8_SCHED;
            } else {
            PG8_LDB(B0, 0, 0); PG8_SCHED; PG8_LDA(At, 0, 0); PG8_STAGE(PG8_SA(1, 1), a1 + hstep, voffA);
            PG8_WAIT_L(8); PG8_BAR; PG8_WAIT_L(0); PG8_MMA(0, 0, At, B0); PG8_BAR; PG8_SCHED;
            PG8_LDB(B1, 0, 1); PG8_STAGE(PG8_SB(0, 0), b2, voffB);
            PG8_BAR; PG8_WAIT_L(0); PG8_MMA(0, 1, At, B1); PG8_BAR;
            PG8_LDA(At, 0, 1); PG8_STAGE(PG8_SA(0, 0), a2, voffA);
            PG8_BAR; PG8_WAIT_L(0); PG8_MMA(1, 0, At, B0); PG8_BAR; PG8_SCHED;
            PG8_STAGE(PG8_SB(0, 1), b2 + hstep, voffB);
            PG8_WAIT_V(6); PG8_BAR; PG8_MMA(1, 1, At, B1); PG8_BAR;
            PG8_LDB(B0, 1, 0); PG8_SCHED; PG8_LDA(At, 1, 0); PG8_STAGE(PG8_SA(0, 1), a2 + hstep, voffA);
            PG8_WAIT_L(8); PG8_BAR; PG8_WAIT_L(0); PG8_MMA(0, 0, At, B0); PG8_BAR; PG8_SCHED;
            PG8_LDB(B1, 1, 1); PG8_STAGE(PG8_SB(1, 0), b3, voffB);
            PG8_BAR; PG8_WAIT_L(0); PG8_MMA(0, 1, At, B1); PG8_BAR;
            PG8_LDA(At, 1, 1); PG8_STAGE(PG8_SA(1, 0), a3, voffA);
            PG8_BAR; PG8_WAIT_L(0); PG8_MMA(1, 0, At, B0); PG8_BAR; PG8_SCHED;
            PG8_STAGE(PG8_SB(1, 1), b3 + hstep, voffB);
            PG8_WAIT_V(6); PG8_BAR; PG8_MMA(1, 1, At, B1); PG8_BAR;
            }
        }
        if constexpr (ALIGN_EPI) { if (wr == 0) PG8_BAR; }
        if constexpr (!Epi::AFTER_DRAIN) { E(acc, cur, wr, wc, fr, fq); S.done(cur); }
        if (!has_next) break;
#pragma unroll
        for (int a = 0; a < 2; ++a)
#pragma unroll
            for (int b = 0; b < 2; ++b)
#pragma unroll
                for (int m = 0; m < 4; ++m)
#pragma unroll
                    for (int n = 0; n < 2; ++n) acc[a][b][m][n] = (f32x4){0.f, 0.f, 0.f, 0.f};
        cur = nxt; cA = nA; cB = nB; ++ui;
        if constexpr (ALIGN_EPI) { if (wr == 1) PG8_BAR; }
    }
    PG8_WAIT_V(0);
    if constexpr (!ALIGN_EPI) { if (wr == 0) PG8_BAR; }
    PG8_BAR;
    if constexpr (Epi::AFTER_DRAIN) { E.fused(acc, cur, wr, wc, fr, fq, lds, wid, lane); S.done(cur); }
#undef PG8_SA
#undef PG8_SB
#undef PG8_STAGE
#undef PG8_LDA
#undef PG8_LDB
#undef PG8_MMA
#undef PG8_WAIT_V
#undef PG8_WAIT_L
#undef PG8_BAR
#undef PG8_SCHED
}
}
#include <hip/hip_bf16.h>
#include <cmath>
namespace attn_body {
using bf16=__hip_bfloat16;
using bf16x8=__attribute__((ext_vector_type(8)))short;
using s16x4=__attribute__((ext_vector_type(4)))short;
using f32x16=__attribute__((ext_vector_type(16)))float;
using u32x4=__attribute__((ext_vector_type(4)))unsigned;
constexpr int D=64,QP=512,KP=128;
constexpr int NW=8,QBLK=32,QB=QBLK*NW,KVBLK=64;
__device__ __forceinline__ int crow(int r,int hi){return (r&3)+8*(r>>2)+4*hi;}
#define SBAR() __builtin_amdgcn_sched_barrier(0)

constexpr int NSLOT=3, SLOTB=8192;
constexpr int LDS_K=0, LDS_V=NSLOT*SLOTB, LDS_WS=2*NSLOT*SLOTB, LDS_OST=LDS_WS+NW*64*4, LDS_BYTES=LDS_OST+NW*4096;
constexpr float C2=0.125f*1.4426950408889634f;
__device__ __forceinline__ void glds16(const void*gsrc,unsigned lds_dst){unsigned keep;
  asm volatile("s_mov_b32 %0, m0\n\ts_mov_b32 m0, %2\n\ts_nop 0\n\tglobal_load_lds_dwordx4 %1, off\n\ts_mov_b32 m0, %0":"=&s"(keep):"v"(gsrc),"s"(lds_dst):"memory");}
__device__ __forceinline__ float max3f(float a,float b,float c){float r;asm("v_max3_f32 %0, %1, %2, %3":"=v"(r):"v"(a),"v"(b),"v"(c));return r;}
__device__ __forceinline__ float max2f(float a,float b){float r;asm("v_max_f32_e32 %0, %1, %2":"=v"(r):"v"(a),"v"(b));return r;}
__device__ __forceinline__ float fadd_s(float a,float b){float r;asm("v_add_f32_e32 %0, %1, %2":"=v"(r):"v"(a),"v"(b));return r;}
__device__ __forceinline__ float fsub_s(float a,float b){float r;asm("v_sub_f32_e32 %0, %1, %2":"=v"(r):"v"(a),"v"(b));return r;}
typedef float f32x2_t __attribute__((ext_vector_type(2))); typedef __bf16 bf16x2_t __attribute__((ext_vector_type(2)));
__device__ __forceinline__ unsigned cvtpk_s(float lo,float hi){f32x2_t v={lo,hi};bf16x2_t b=__builtin_convertvector(v,bf16x2_t);return __builtin_bit_cast(unsigned,b);}
#define WAIT_BAR(N) asm volatile("s_waitcnt vmcnt(" #N ") lgkmcnt(0)\n\ts_barrier":::"memory")

__device__ __forceinline__ void qkt(f32x16&p0,f32x16&p1,const char*Kslot,const bf16x8*qr,const f32x16&negm,int r32,int hi){
  const char*kb=Kslot+hi*1024+r32*16;
  #pragma unroll
  for(int d0=0;d0<4;++d0){
    const bf16x8 b0=*reinterpret_cast<const bf16x8*>(kb+d0*2048);
    const bf16x8 b1=*reinterpret_cast<const bf16x8*>(kb+d0*2048+512);
    if(d0==0){p0=__builtin_amdgcn_mfma_f32_32x32x16_bf16(b0,qr[0],negm,0,0,0);p1=__builtin_amdgcn_mfma_f32_32x32x16_bf16(b1,qr[0],negm,0,0,0);}
    else{p0=__builtin_amdgcn_mfma_f32_32x32x16_bf16(b0,qr[d0],p0,0,0,0);p1=__builtin_amdgcn_mfma_f32_32x32x16_bf16(b1,qr[d0],p1,0,0,0);}}
}
typedef __attribute__((address_space(3))) const char* lds_cptr;
typedef short v4i16_t __attribute__((ext_vector_type(4)));
__device__ __forceinline__ void kload8(bf16x8*kf,lds_cptr kp){
  kf[0]=*(const __attribute__((address_space(3))) bf16x8*)(kp);      kf[1]=*(const __attribute__((address_space(3))) bf16x8*)(kp+512);
  kf[2]=*(const __attribute__((address_space(3))) bf16x8*)(kp+2048); kf[3]=*(const __attribute__((address_space(3))) bf16x8*)(kp+2560);
  kf[4]=*(const __attribute__((address_space(3))) bf16x8*)(kp+4096); kf[5]=*(const __attribute__((address_space(3))) bf16x8*)(kp+4608);
  kf[6]=*(const __attribute__((address_space(3))) bf16x8*)(kp+6144); kf[7]=*(const __attribute__((address_space(3))) bf16x8*)(kp+6656);
}
__device__ __forceinline__ void kload2(bf16x8*kf,lds_cptr kp,int j){ kf[2*j]=*(const __attribute__((address_space(3))) bf16x8*)(kp+j*2048); kf[2*j+1]=*(const __attribute__((address_space(3))) bf16x8*)(kp+j*2048+512); }
__device__ __forceinline__ s16x4 vtr(lds_cptr p){ return __builtin_bit_cast(s16x4,__builtin_amdgcn_ds_read_tr16_b64_v4i16((__attribute__((address_space(3))) v4i16_t*)p)); }
__device__ __forceinline__ float rowmax(const f32x16&p0,const f32x16&p1){
  float a=max3f(p0[0],p0[1],p1[0]),b=max3f(p0[2],p0[3],p1[1]);a=max3f(a,p1[2],p1[3]);
  #pragma unroll
  for(int r=4;r<16;r+=4){a=max3f(a,p0[r],p0[r+1]);b=max3f(b,p0[r+2],p0[r+3]);a=max3f(a,p1[r],p1[r+1]);b=max3f(b,p1[r+2],p1[r+3]);}
  const float m=max2f(a,b);
  auto rr=__builtin_amdgcn_permlane32_swap(__float_as_uint(m),__float_as_uint(m),false,false);
  return max2f(__uint_as_float(rr[0]),__uint_as_float(rr[1]));
}
__device__ __forceinline__ void pv(f32x16*o,int vb,bf16x8 pa0,bf16x8 pa1,bf16x8 pa2,bf16x8 pa3){
  #pragma unroll
  for(int d0=0;d0<2;++d0){s16x4 lo[4],hi[4];
    #pragma unroll
    for(int ks=0;ks<4;++ks){
      asm volatile("ds_read_b64_tr_b16 %0,%1 offset:%c2":"=&v"(lo[ks]):"v"(vb),"i"(d0*4096+ks*1024):"memory");
      asm volatile("ds_read_b64_tr_b16 %0,%1 offset:%c2":"=&v"(hi[ks]):"v"(vb),"i"(d0*4096+ks*1024+512):"memory");}
    asm volatile("s_waitcnt lgkmcnt(0)":::"memory");SBAR();
    #define PK(k) (bf16x8){lo[k][0],lo[k][1],lo[k][2],lo[k][3],hi[k][0],hi[k][1],hi[k][2],hi[k][3]}
    o[d0]=__builtin_amdgcn_mfma_f32_32x32x16_bf16(pa0,PK(0),o[d0],0,0,0);
    o[d0]=__builtin_amdgcn_mfma_f32_32x32x16_bf16(pa1,PK(1),o[d0],0,0,0);
    o[d0]=__builtin_amdgcn_mfma_f32_32x32x16_bf16(pa2,PK(2),o[d0],0,0,0);
    o[d0]=__builtin_amdgcn_mfma_f32_32x32x16_bf16(pa3,PK(3),o[d0],0,0,0);
    #undef PK
  }
}

#ifndef ATTN_STORE16
#define ATTN_STORE16(p,v) (*(u32x4*)(p)=(v))
#endif
template<int THRL> __device__ __forceinline__ void attn_unit(long rowbase,int T,int h,int qb,const bf16*Q,const bf16*__restrict__ K,const bf16*__restrict__ V,bf16*O,char*shm){
  const int tid=pg8::opaque_tid(),lane=tid&63,r32=lane&31,hi=lane>>5; const int wid=__builtin_amdgcn_readfirstlane(tid>>6);
  const int q0=qb*QB;
  const bf16*Qw=Q+(rowbase+q0+wid*QBLK)*QP+h*D;
  const bf16*Kh=K+rowbase*KP+(h>>2)*D,*Vh=V+rowbase*KP+(h>>2)*D;
  const unsigned lds0=(unsigned)(uintptr_t)shm;
  float*wsf=(float*)(shm+LDS_WS)+wid*64;
  const bf16*ksrc=Kh+(long)lane*KP+wid*8;
  const bf16*vsrc=Vh+(long)(16*(wid&3)+(lane>>2))*KP+(wid>>2)*32+(lane&3)*8;
  const unsigned kdst=lds0+LDS_K+wid*1024, vdst=lds0+LDS_V+wid*1024;
  #define DMA_K(t,slot) glds16(ksrc+(long)(t)*KVBLK*KP,(unsigned)__builtin_amdgcn_readfirstlane(kdst+(slot)))
  #define DMA_V(t,slot) glds16(vsrc+(long)(t)*KVBLK*KP,(unsigned)__builtin_amdgcn_readfirstlane(vdst+(slot)))
  const int vb0=(int)(lds0+LDS_V)+((lane>>4)&1)*32+(lane&3)*8+(4*hi+((lane&15)>>2))*64;
  const char*Kbase=shm+LDS_K; bf16x8 kf[8];
  const lds_cptr shm3=(lds_cptr)shm; const lds_cptr kp0=shm3+LDS_K+hi*1024+r32*16; const lds_cptr vp0=shm3+LDS_V+((lane>>4)&1)*32+(lane&3)*8+(4*hi+((lane&15)>>2))*64;
  const int NT=T/KVBLK;
  DMA_K(0,0);DMA_V(0,0);DMA_K(1,SLOTB);
  bf16x8 qr[4];
  #pragma unroll
  for(int d0=0;d0<4;++d0)qr[d0]=*reinterpret_cast<const bf16x8*>(&Qw[(long)r32*QP+d0*16+hi*8]);
  float mhat=0.f,l_reg=0.f;f32x16 o[2];o[0]=f32x16{};o[1]=f32x16{};f32x16 negm=f32x16{};asm volatile("":"+v"(negm));
  #define CMASK(P0,P1,t) do{}while(0)
  bool resc=false;
  #define START(P0,P1) do{ const float rm=rowmax(P0,P1); resc=false; \
    { const float dl=rm; mhat=fadd_s(mhat,dl); \
      _Pragma("unroll") for(int r=0;r<16;++r){P0[r]=fsub_s(P0[r],dl);P1[r]=fsub_s(P1[r],dl);} \
      _Pragma("unroll") for(int r=0;r<16;++r)negm[r]=-mhat; asm volatile("":"+v"(negm)); } \
    _Pragma("unroll") for(int r=0;r<16;++r)P0[r]=__builtin_amdgcn_exp2f(P0[r]); }while(0)
  #define RESC() do{ if(resc){ asm volatile("s_waitcnt lgkmcnt(0)":::"memory"); \
      _Pragma("unroll") for(int d_=0;d_<2;++d_) _Pragma("unroll") for(int r=0;r<16;++r)o[d_][r]*=wsf[crow(r,hi)]; } }while(0)
  f32x16 pA0,pA1,pB0,pB1;
  int sl_prev=0,sl_cur=0,sl_next=SLOTB;
  #define ROT() do{sl_prev=sl_cur;sl_cur=sl_next;sl_next=(sl_next==(NSLOT-1)*SLOTB)?0:sl_next+SLOTB;}while(0)
  DMA_K(2,2*SLOTB);
  WAIT_BAR(3);
  qkt(pA0,pA1,Kbase,qr,negm,r32,hi);asm volatile("s_nop 15\n\ts_nop 7":"+v"(pA0),"+v"(pA1));CMASK(pA0,pA1,0);
  START(pA0,pA1);
  _Pragma("unroll") for(int r=0;r<16;++r)pA1[r]=__builtin_amdgcn_exp2f(pA1[r]);
  WAIT_BAR(0);
  DMA_K(3,0);DMA_V(1,SLOTB);
  ROT();
  kload8(kf,kp0+sl_cur);
  WAIT_BAR(2);
  s16x4 vlo[8],vhi[8]; u32x4 pw0,pw1,pw2,pw3;
  #define PKW(P,B) cvtpk_s(P[B],P[B+1])
  #define PAF(k) __builtin_bit_cast(bf16x8,pw##k)
  #define VFR(i) (bf16x8){vlo[i][0],vlo[i][1],vlo[i][2],vlo[i][3],vhi[i][0],vhi[i][1],vhi[i][2],vhi[i][3]}
  #define PIN(x) asm volatile("":"+v"(x))
  #define MX3(a,b,c) __builtin_fmaxf(__builtin_fmaxf((a),(b)),(c))
  #define GAPA(MF,A0,A1,A2,A3,W0,W1,PW) do{ MF; sacc+=A0; sacc+=A1; sacc+=A2; sacc+=A3; PIN(sacc); W0; W1; PIN(PW); SBAR(); }while(0)
  #define EX(v) __builtin_amdgcn_exp2f(v)
  #define GAPB(MF,X,B) do{ MF; X[B]=EX(X[B]); X[B+1]=EX(X[B+1]); X[B+2]=EX(X[B+2]); X[B+3]=EX(X[B+3]); PIN(X); SBAR(); }while(0)
  #define VRD(i) do{ vlo[i]=vtr(vp_+(((i)>>2)*4096+((i)&3)*1024)); vhi[i]=vtr(vp_+(((i)>>2)*4096+((i)&3)*1024+512)); }while(0)
  #define KRD(G,j) do{ if(G){ kload2(kf,kp0+sl_next,j); SBAR(); } }while(0)
  #define STEP(C0,C1,P0,P1,t,GK,GV,GL) do{ SBAR(); \
    const lds_cptr vp_=vp0+sl_prev; \
    VRD(0); SBAR(); float sacc=(P0[0]+P0[1]); \
    GAPA(C0=__builtin_amdgcn_mfma_f32_32x32x16_bf16(kf[0],qr[0],negm,0,0,0), P0[2],P0[3],P0[4],P0[5],     pw0[0]=PKW(P0,0), pw0[1]=PKW(P0,2), pw0); \
    VRD(4); SBAR(); GAPA(C1=__builtin_amdgcn_mfma_f32_32x32x16_bf16(kf[1],qr[0],negm,0,0,0), P0[6],P0[7],P0[8],P0[9],     pw0[2]=PKW(P0,4), pw0[3]=PKW(P0,6), pw0); \
    VRD(1); SBAR(); GAPA(C0=__builtin_amdgcn_mfma_f32_32x32x16_bf16(kf[2],qr[1],C0,0,0,0),   P0[10],P0[11],P0[12],P0[13], pw1[0]=PKW(P0,8), pw1[1]=PKW(P0,10), pw1); \
    VRD(5); SBAR(); GAPA(C1=__builtin_amdgcn_mfma_f32_32x32x16_bf16(kf[3],qr[1],C1,0,0,0),   P0[14],P0[15],P1[0],P1[1],   pw1[2]=PKW(P0,12),pw1[3]=PKW(P0,14), pw1); \
    VRD(2); SBAR(); GAPA(C0=__builtin_amdgcn_mfma_f32_32x32x16_bf16(kf[4],qr[2],C0,0,0,0),   P1[2],P1[3],P1[4],P1[5],     pw2[0]=PKW(P1,0), pw2[1]=PKW(P1,2), pw2); \
    VRD(6); SBAR(); GAPA(C1=__builtin_amdgcn_mfma_f32_32x32x16_bf16(kf[5],qr[2],C1,0,0,0),   P1[6],P1[7],P1[8],P1[9],     pw2[2]=PKW(P1,4), pw2[3]=PKW(P1,6), pw2); \
    VRD(3); SBAR(); GAPA(C0=__builtin_amdgcn_mfma_f32_32x32x16_bf16(kf[6],qr[3],C0,0,0,0),   P1[10],P1[11],P1[12],P1[13], pw3[0]=PKW(P1,8), pw3[1]=PKW(P1,10), pw3); \
    VRD(7); SBAR(); GAPA(C1=__builtin_amdgcn_mfma_f32_32x32x16_bf16(kf[7],qr[3],C1,0,0,0),   P1[14],P1[15],0.f,0.f,       pw3[2]=PKW(P1,12),pw3[3]=PKW(P1,14), pw3); \
    l_reg+=sacc; \
    if(GK){DMA_K((t)+3,sl_cur);} if(GV){DMA_V((t)+1,sl_next);} \
    CMASK(C0,C1,t); \
    { float a=MX3(C0[0],C0[1],C1[0]),b=MX3(C0[2],C0[3],C1[1]); a=MX3(a,C1[2],C1[3]); \
      _Pragma("unroll") for(int r=4;r<16;r+=4){a=MX3(a,C0[r],C0[r+1]);b=MX3(b,C0[r+2],C0[r+3]);a=MX3(a,C1[r],C1[r+1]);b=MX3(b,C1[r+2],C1[r+3]);} \
      float rm=__builtin_fmaxf(a,b); { auto rr=__builtin_amdgcn_permlane32_swap(__float_as_uint(rm),__float_as_uint(rm),false,false); rm=__builtin_fmaxf(__uint_as_float(rr[0]),__uint_as_float(rr[1])); } \
      resc=false; \
      if(__builtin_expect(__any(rm>(float)THRL),0)){ const float dl=__builtin_fmaxf(rm,0.f); mhat+=dl; \
        _Pragma("unroll") for(int r=0;r<16;++r){C0[r]-=dl;C1[r]-=dl;} \
        _Pragma("unroll") for(int r=0;r<16;++r)negm[r]=-mhat; asm volatile("":"+v"(negm)); \
        const float f=__builtin_amdgcn_exp2f(-dl); l_reg*=f; if(hi==0)wsf[r32]=f; resc=true; } } \
    SBAR(); \
    GAPB(o[0]=__builtin_amdgcn_mfma_f32_32x32x16_bf16(PAF(0),VFR(0),o[0],0,0,0), C0,0); \
    GAPB(o[1]=__builtin_amdgcn_mfma_f32_32x32x16_bf16(PAF(0),VFR(4),o[1],0,0,0), C0,4); \
    KRD(GL,0); GAPB(o[0]=__builtin_amdgcn_mfma_f32_32x32x16_bf16(PAF(1),VFR(1),o[0],0,0,0), C0,8); \
    KRD(GL,1); GAPB(o[1]=__builtin_amdgcn_mfma_f32_32x32x16_bf16(PAF(1),VFR(5),o[1],0,0,0), C0,12); \
    KRD(GL,2); GAPB(o[0]=__builtin_amdgcn_mfma_f32_32x32x16_bf16(PAF(2),VFR(2),o[0],0,0,0), C1,0); \
    KRD(GL,3); GAPB(o[1]=__builtin_amdgcn_mfma_f32_32x32x16_bf16(PAF(2),VFR(6),o[1],0,0,0), C1,4); \
    GAPB(o[0]=__builtin_amdgcn_mfma_f32_32x32x16_bf16(PAF(3),VFR(3),o[0],0,0,0), C1,8); \
    GAPB(o[1]=__builtin_amdgcn_mfma_f32_32x32x16_bf16(PAF(3),VFR(7),o[1],0,0,0), C1,12); \
    }while(0)
  int t=1;
  #undef CMASK
  #define CMASK(P0,P1,t) do{}while(0)
  for(;t+5<NT;t+=2){
    STEP(pB0,pB1,pA0,pA1,t,true,true,true);     WAIT_BAR(2); RESC(); ROT();
    STEP(pA0,pA1,pB0,pB1,t+1,true,true,true);   WAIT_BAR(2); RESC(); ROT();
  }
  #undef CMASK
  #define CMASK(P0,P1,t) do{}while(0)
  #define ENDW(tt) do{ if((tt)+3<NT){WAIT_BAR(2);} else if((tt)+2<NT){WAIT_BAR(1);} else {WAIT_BAR(0);} }while(0)
  for(;t+1<NT;t+=2){
    STEP(pB0,pB1,pA0,pA1,t,(t+3<NT),(t+1<NT),(t+1<NT));       ENDW(t);   RESC(); ROT();
    STEP(pA0,pA1,pB0,pB1,t+1,(t+4<NT),(t+2<NT),(t+2<NT));     ENDW(t+1); RESC(); ROT();
  }
  STEP(pB0,pB1,pA0,pA1,NT-1,false,false,false); RESC();
  { float sacc=pB0[0]+pB0[1]; _Pragma("unroll") for(int r=2;r<16;++r)sacc+=pB0[r]; _Pragma("unroll") for(int r=0;r<16;++r)sacc+=pB1[r]; l_reg+=sacc;
    pw0=(u32x4){PKW(pB0,0),PKW(pB0,2),PKW(pB0,4),PKW(pB0,6)};pw1=(u32x4){PKW(pB0,8),PKW(pB0,10),PKW(pB0,12),PKW(pB0,14)};pw2=(u32x4){PKW(pB1,0),PKW(pB1,2),PKW(pB1,4),PKW(pB1,6)};pw3=(u32x4){PKW(pB1,8),PKW(pB1,10),PKW(pB1,12),PKW(pB1,14)};
    SBAR(); pv(o,vb0+sl_cur,PAF(0),PAF(1),PAF(2),PAF(3)); }
  #undef PKW
  #undef PAF
  #undef VFR
  #undef PIN
  #undef MX3
  #undef GAPA
  #undef GAPB
  #undef EX
  #undef VRD
  #undef KRD
  #undef STEP
  #undef ENDW
  {auto rr=__builtin_amdgcn_permlane32_swap(__float_as_uint(l_reg),__float_as_uint(l_reg),false,false);l_reg=__uint_as_float(rr[0])+__uint_as_float(rr[1]);}
  if(hi==0)wsf[32+r32]=l_reg;asm volatile("s_waitcnt lgkmcnt(0)":::"memory");
  float rli[16];
  #pragma unroll
  for(int r=0;r<16;++r)rli[r]=__builtin_amdgcn_rcpf(wsf[32+crow(r,hi)]);
  bf16*Ow=O+(rowbase+q0+wid*QBLK)*QP+h*D;
  { bf16*stg=(bf16*)(shm+LDS_OST)+wid*2048;
    #pragma unroll
    for(int r=0;r<16;++r){const int orow=crow(r,hi);
      #pragma unroll
      for(int d0=0;d0<2;++d0)stg[orow*64+d0*32+r32]=__float2bfloat16(o[d0][r]*rli[r]);}
    asm volatile("s_waitcnt lgkmcnt(0)":::"memory");
    #pragma unroll
    for(int i=0;i<4;++i){const int row=i*8+(lane>>3),ch=lane&7; const u32x4 v=*(const u32x4*)(stg+row*64+ch*8); ATTN_STORE16(Ow+(long)row*QP+ch*8,v);} }
  asm volatile("s_waitcnt lgkmcnt(0)\n\ts_barrier":::"memory");
  #undef DMA_K
  #undef DMA_V
  #undef CMASK
  #undef START
  #undef RESC
  #undef ROT
}
constexpr int ATTN_LDS_BYTES=LDS_BYTES;
#undef SBAR
#undef WAIT_BAR
}
#define LAS __attribute__((address_space(3)))
typedef unsigned short bf16_t;
typedef unsigned v4u __attribute__((ext_vector_type(4)));
typedef unsigned v2u __attribute__((ext_vector_type(2)));
typedef float f32x4 __attribute__((ext_vector_type(4)));
typedef short bf16x8 __attribute__((ext_vector_type(8)));
typedef short s16x4 __attribute__((ext_vector_type(4)));

constexpr int NWAVES = 8, NTHREADS = 512;
constexpr int M_TOK = 49152, DMODEL = 1024, DFF = 2816, NPROJ = 2304, DEPTH = 4;
constexpr int PROMPT_ROWS = 16384;
constexpr int NCHUNK = M_TOK / 128;
constexpr int NRET_ITEMS = NCHUNK * 4;
constexpr float NORM_EPS = 1e-6f;
constexpr float ATT_C2 = 0.125f * 1.4426950408889634f;

constexpr size_t OW13A = 0, OW2A = OW13A + (size_t)5632 * 1024, OWIN = OW2A + (size_t)1024 * 2816, OWG = OWIN + (size_t)2304 * 1024, OWBA = OWG + (size_t)2048 * 1024,
                 OWBR = OWBA + (size_t)1024 * 512, OWO = OWBR + (size_t)1024 * 512, OW13B = OWO + (size_t)1024 * 1024, OW2B = OW13B + (size_t)5632 * 1024, OWEND = OW2B + (size_t)1024 * 2816;
constexpr size_t MiB = 1u << 20;
constexpr size_t WS_ROPE = 0;
constexpr size_t WS_BAR = 65536;
constexpr int LDS_MISC = 131072;
constexpr size_t WS_WB = 1 * MiB;
constexpr size_t WS_XN = 48 * MiB;
constexpr size_t WS_B = 144 * MiB;
constexpr size_t WS_HB = WS_B;
constexpr size_t WS_Q = WS_B, WS_K = WS_B + 48 * MiB, WS_V = WS_B + 60 * MiB, WS_RQ = WS_B + 72 * MiB, WS_RK = WS_B + 96 * MiB, WS_RV = WS_B + 120 * MiB, WS_RG = WS_B + 168 * MiB,
                 WS_T = WS_B + 216 * MiB, WS_ST = WS_B + 312 * MiB, WS_U = WS_B;
constexpr size_t WS_SS = WS_B + 360 * MiB;
constexpr size_t WS_WB1 = WS_SS + 3 * MiB;
constexpr size_t WS_END = WS_WB1 + 46 * MiB;
static_assert(OWEND * 2 + WS_WB <= WS_XN && (size_t)M_TOK * DFF * 2 <= 264 * MiB, "ws map");
static_assert(WS_Q == WS_B + 2 * pg8::EpiInProj::EQ && WS_K == WS_B + 2 * pg8::EpiInProj::EK && WS_V == WS_B + 2 * pg8::EpiInProj::EV && WS_RQ == WS_B + 2 * pg8::EpiInProj::ERQ && WS_RK == WS_B + 2 * pg8::EpiInProj::ERK && WS_RV == WS_B + 2 * pg8::EpiInProj::ERV && WS_RG == WS_B + 2 * pg8::EpiInProj::ERG, "in-proj epilogue offsets");

constexpr int LDS_BYTES = 147456;
constexpr int NPHASE = 1 + 11 * DEPTH + 1;

__device__ __forceinline__ unsigned f2bf(float f) { unsigned u = __builtin_bit_cast(unsigned, f); return (u + 0x7fffu + ((u >> 16) & 1u)) >> 16; }
__device__ __forceinline__ unsigned pk2(float lo, float hi) { return pg8::cvt_pk_bf16(lo, hi); }
__device__ __forceinline__ float bfl(unsigned w) { return __uint_as_float(w << 16); }
__device__ __forceinline__ float bfh(unsigned w) { return __uint_as_float(w & 0xffff0000u); }
__device__ __forceinline__ float wave_sum(float v) {
#pragma unroll
    for (int o = 1; o < 64; o <<= 1) v += __shfl_xor(v, o);
    return v;
}
#define LDS_WAIT() asm volatile("s_waitcnt lgkmcnt(0)" ::: "memory")

#define RLX_AGENT __ATOMIC_RELAXED, __HIP_MEMORY_SCOPE_AGENT
#define XB_TMO      128
#define XB_XCNT(j)  (256  + 64 * (j))
#define XB_XSUB(j)  (1280 + 64 * (j))
#define XB_XGEN(j)  (2304 + 64 * (j))
#define XB_TOP      3328
#define XB_TOPGEN   3392
#define XCD_BAR_WORDS 3456
#define XB_SPIN_CAP (1u << 18)

__device__ __forceinline__ unsigned xb_ld(unsigned* p)              { return __hip_atomic_load(p, __ATOMIC_RELAXED, __HIP_MEMORY_SCOPE_AGENT); }
__device__ __forceinline__ unsigned xb_add(unsigned* p, unsigned v) { return __hip_atomic_fetch_add(p, v, __ATOMIC_RELAXED, __HIP_MEMORY_SCOPE_AGENT); }
__device__ __forceinline__ unsigned xb_xcc_id() { return (unsigned)__builtin_amdgcn_s_getreg((3 << 11) | 20) & 0xFu; }
#define XB_SPIN(cond, bar) do { unsigned _sp = 0; while (cond) { __builtin_amdgcn_s_sleep(1); \
    if ((++_sp & 255u) == 0u) { if (xb_ld(&(bar)[XB_TMO])) break; if (_sp > XB_SPIN_CAP) { atomicAdd(&(bar)[XB_TMO], 1u); break; } } } } while (0)

struct XcdBarrier {
    unsigned* bar; unsigned x;
    volatile LAS unsigned* st;
};

__device__ __forceinline__ XcdBarrier xcd_barrier_post(unsigned* bar, volatile LAS unsigned* st) {
    XcdBarrier b; b.bar = bar; b.x = xb_xcc_id(); b.st = st;
    if (threadIdx.x == 0) (void)xb_add(&bar[XB_XCNT(b.x)], 1u);
    return b;
}
__device__ __forceinline__ void xcd_barrier_complete(unsigned* bar, unsigned x, unsigned& nloc, unsigned& nx) {
    const unsigned G = gridDim.x * gridDim.y * gridDim.z;
    unsigned sum, cnt, mine, sp = 0u;
    for (;;) {
        sum = 0u; cnt = 0u; mine = 0u;
#pragma unroll
        for (unsigned j = 0; j < 16; ++j) { const unsigned c = xb_ld(&bar[XB_XCNT(j)]); sum += c; cnt += (c > 0u) ? 1u : 0u; mine = (j == x) ? c : mine; }
        if (sum == G) break;
        __builtin_amdgcn_s_sleep(1);
        if ((++sp & 255u) == 0u) { if (xb_ld(&bar[XB_TMO])) break; if (sp > XB_SPIN_CAP) { atomicAdd(&bar[XB_TMO], 1u); break; } }
    }
    nloc = mine > 0u ? mine : 1u; nx = cnt > 0u ? cnt : 1u;
}

__device__ __forceinline__ void xcd_barrier(const XcdBarrier& b) {
    asm volatile("s_waitcnt vmcnt(0)" ::: "memory");
    __syncthreads();
    if (threadIdx.x == 0) {
        unsigned* bar = b.bar;
        __builtin_amdgcn_s_waitcnt(0);
        unsigned nloc = b.st[0], nx = b.st[1];
        if (nloc == 0u) { xcd_barrier_complete(bar, b.x, nloc, nx); b.st[0] = nloc; b.st[1] = nx; }
        const unsigned old = xb_add(&bar[XB_XSUB(b.x)], 1u);
        const unsigned gen = old / nloc;
        if (old + 1u == (gen + 1u) * nloc) {
            __builtin_amdgcn_fence(__ATOMIC_RELEASE, "agent");
            asm volatile("s_waitcnt vmcnt(0)" ::: "memory");
            const unsigned og = xb_add(&bar[XB_TOP], 1u);
            const unsigned tg = og / nx;
            if (og + 1u == (tg + 1u) * nx) xb_add(&bar[XB_TOPGEN], 1u);
            else XB_SPIN(xb_ld(&bar[XB_TOPGEN]) == tg, bar);
            __builtin_amdgcn_fence(__ATOMIC_ACQUIRE, "agent");
            xb_add(&bar[XB_XGEN(b.x)], 1u);
            asm volatile("s_waitcnt vmcnt(0)" ::: "memory");
        } else {
            XB_SPIN(xb_ld(&bar[XB_XGEN(b.x)]) == gen, bar);
            __builtin_amdgcn_fence(__ATOMIC_ACQUIRE, "agent");
            asm volatile("s_waitcnt vmcnt(0)" ::: "memory");
        }
    }
    __syncthreads();
}

__device__ __forceinline__ void transpose_item(const float* W, const float* gk, int K, int N, bf16_t* WT, int map, LAS float* scr, int item, int lane) {
    const int nblk = N / 32, kb = item / nblk, nb = item % nblk, k0 = 64 * kb, n0 = 32 * nb;
    int drow0 = n0;
    if (map == 1) { const int half = n0 / DFF, j = n0 % DFF; drow0 = 256 * (j / 128) + 128 * half + (j % 128); }
    else if (map == 3) { const int half = n0 / 1024, j = n0 % 1024; drow0 = 256 * (j / 128) + 128 * half + (j % 128); }
    else if (map == 2) { const int pn = n0 / 256, r = n0 % 256; drow0 = 256 * pn + 128 * ((r % 64) / 32) + 32 * (r / 64); }
    { const int kr = lane >> 3, nq = (lane & 7) * 4;
        f32x4 v[8]; float gs[8];
#pragma unroll
        for (int i = 0; i < 8; ++i) { v[i] = *(const f32x4*)(W + (size_t)(k0 + 8 * i + kr) * N + n0 + nq); gs[i] = gk ? gk[k0 + 8 * i + kr] : 1.f; }
#pragma unroll
        for (int i = 0; i < 8; ++i) { LAS float* d = scr + (8 * i + kr) * 33 + nq; d[0] = v[i][0] * gs[i]; d[1] = v[i][1] * gs[i]; d[2] = v[i][2] * gs[i]; d[3] = v[i][3] * gs[i]; } }
    LDS_WAIT(); asm volatile("" ::: "memory");
    const int c = lane & 7;
#pragma unroll
    for (int j = 0; j < 4; ++j) { const int n = (lane >> 3) + 8 * j; const LAS float* s = scr + (8 * c) * 33 + n;
        v4u o; o.x = pk2(s[0 * 33], s[1 * 33]); o.y = pk2(s[2 * 33], s[3 * 33]); o.z = pk2(s[4 * 33], s[5 * 33]); o.w = pk2(s[6 * 33], s[7 * 33]);
        *(v4u*)(WT + (size_t)(drow0 + n) * K + k0 + 8 * c) = o; }
    LDS_WAIT(); asm volatile("" ::: "memory");
}

struct Args { const float* in[21]; float* out; unsigned char* ws; int ph_lo, ph_hi; };

template <bool OUT_F32> __device__ __forceinline__ void norm_row(const float* xrow, const float* g, bf16_t* orow, float* orow_f, int lane) {
    const f32x4* xr = (const f32x4*)xrow + lane; const f32x4* gr = (const f32x4*)g + lane;
    f32x4 v[4]; float s = 0.f;
#pragma unroll
    for (int j = 0; j < 4; ++j) { v[j] = xr[64 * j]; s += (v[j].x * v[j].x + v[j].y * v[j].y) + (v[j].z * v[j].z + v[j].w * v[j].w); }
    const float rstd = 1.0f / sqrtf(wave_sum(s) * (1.0f / 1024.0f) + NORM_EPS);
#pragma unroll
    for (int j = 0; j < 4; ++j) { const f32x4 gg = gr[64 * j]; const f32x4 o = v[j] * rstd * gg;
        if (OUT_F32) ((f32x4*)orow_f)[64 * j + lane] = o;
        else { v2u w; w.x = pk2(o.x, o.y); w.y = pk2(o.z, o.w); ((v2u*)orow)[64 * j + lane] = w; } }
}

__device__ __forceinline__ void final_row(const bf16_t* hrow, const float* ssrow, const float* g, float* orow, int lane) {
    const f32x4* sp = (const f32x4*)ssrow; const f32x4 a = sp[0], b = sp[1], c = sp[2], d = sp[3];
    const float s = ((a[0] + a[1]) + (a[2] + a[3])) + ((b[0] + b[1]) + (b[2] + b[3])) + ((c[0] + c[1]) + (c[2] + c[3])) + ((d[0] + d[1]) + (d[2] + d[3]));
    const float rstd = __builtin_amdgcn_rsqf(s * (1.0f / 1024.0f) + NORM_EPS);
#pragma unroll
    for (int j = 0; j < 2; ++j) { const v4u hw = ((const v4u*)hrow)[64 * j + lane]; const int cc = 8 * (64 * j + lane);
        f32x4 x0, x1; x0[0] = bfl(hw.x); x0[1] = bfh(hw.x); x0[2] = bfl(hw.y); x0[3] = bfh(hw.y); x1[0] = bfl(hw.z); x1[1] = bfh(hw.z); x1[2] = bfl(hw.w); x1[3] = bfh(hw.w);
        const f32x4 g0 = *(const f32x4*)(g + cc), g1 = *(const f32x4*)(g + cc + 4);
        *(f32x4*)(orow + cc) = x0 * rstd * g0; *(f32x4*)(orow + cc + 4) = x1 * rstd * g1; }
}

__device__ __forceinline__ float log2_gamma(float logit) { return log1pf(-expf(logit)) * 1.4426950408889634f; }

__device__ __forceinline__ f32x4 mfma16(bf16x8 a, bf16x8 b, f32x4 c) { return __builtin_amdgcn_mfma_f32_16x16x32_bf16(a, b, c, 0, 0, 0); }

__device__ __forceinline__ void ret_local_states(LAS unsigned char* lds, const bf16_t* RK, const bf16_t* RV, bf16_t* ST, const float* dec_f, const float* dec_b, int G, int bx, int tid) {
    LAS bf16_t* KTF = (LAS bf16_t*)lds; LAS bf16_t* KTB = KTF + 64 * 136; LAS bf16_t* VT = KTB + 64 * 136;
    const int lane = tid & 63, w = tid >> 6, fr = lane & 15, fq = lane >> 4;
    for (int it = bx; it < NRET_ITEMS; it += G) {
        const int ng = it >> 2, h = it & 3, row0 = ng * 128;
        const float lgf = log2_gamma(dec_f[h]), lgb = log2_gamma(dec_b[h]);
        v4u kw[2], vw[4];
#pragma unroll
        for (int r = 0; r < 2; ++r) { const int idx = tid + 512 * r, j = idx & 127, dc = idx >> 7; kw[r] = *(const v4u*)(RK + (size_t)(row0 + j) * 256 + h * 64 + 8 * dc); }
#pragma unroll
        for (int r = 0; r < 4; ++r) { const int idx = tid + 512 * r, j = idx & 127, ec = idx >> 7; vw[r] = *(const v4u*)(RV + (size_t)(row0 + j) * 512 + h * 128 + 8 * ec); }
#pragma unroll
        for (int r = 0; r < 2; ++r) { const int idx = tid + 512 * r, j = idx & 127, dc = idx >> 7;
            const v4u wv = kw[r];
            const float df = __builtin_amdgcn_exp2f((float)(127 - j) * lgf), db = __builtin_amdgcn_exp2f((float)j * lgb);
            float v[8]; v[0] = bfl(wv.x); v[1] = bfh(wv.x); v[2] = bfl(wv.y); v[3] = bfh(wv.y); v[4] = bfl(wv.z); v[5] = bfh(wv.z); v[6] = bfl(wv.w); v[7] = bfh(wv.w);
#pragma unroll
            for (int i = 0; i < 8; ++i) { KTF[(8 * dc + i) * 136 + j] = (bf16_t)f2bf(v[i] * df); KTB[(8 * dc + i) * 136 + j] = (bf16_t)f2bf(v[i] * db); } }
#pragma unroll
        for (int r = 0; r < 4; ++r) { const int idx = tid + 512 * r, j = idx & 127, ec = idx >> 7;
            const v4u wv = vw[r];
            const unsigned ww[4] = {wv.x, wv.y, wv.z, wv.w};
#pragma unroll
            for (int i = 0; i < 4; ++i) { VT[(8 * ec + 2 * i) * 136 + j] = (bf16_t)(ww[i] & 0xffffu); VT[(8 * ec + 2 * i + 1) * 136 + j] = (bf16_t)(ww[i] >> 16); } }
        __syncthreads();
        f32x4 af[4], ab[4];
#pragma unroll
        for (int d = 0; d < 4; ++d) { af[d] = (f32x4){0.f, 0.f, 0.f, 0.f}; ab[d] = af[d]; }
#pragma unroll
        for (int s = 0; s < 4; ++s) {
            const bf16x8 vb = *(const LAS bf16x8*)(VT + (16 * w + fr) * 136 + 32 * s + 8 * fq);
#pragma unroll
            for (int d = 0; d < 4; ++d) {
                const bf16x8 kf = *(const LAS bf16x8*)(KTF + (16 * d + fr) * 136 + 32 * s + 8 * fq);
                const bf16x8 kb = *(const LAS bf16x8*)(KTB + (16 * d + fr) * 136 + 32 * s + 8 * fq);
                af[d] = mfma16(kf, vb, af[d]); ab[d] = mfma16(kb, vb, ab[d]);
            }
        }
        bf16_t* so = ST + (size_t)it * 16384 + (size_t)(16 * w + fr) * 64 + 4 * fq;
#pragma unroll
        for (int d = 0; d < 4; ++d) {
            v2u o; o.x = pk2(af[d][0], af[d][1]); o.y = pk2(af[d][2], af[d][3]); *(v2u*)(so + 16 * d) = o;
            o.x = pk2(ab[d][0], ab[d][1]); o.y = pk2(ab[d][2], ab[d][3]); *(v2u*)(so + 8192 + 16 * d) = o;
        }
        __syncthreads();
    }
}

__device__ __forceinline__ void ret_chain(bf16_t* ST, int cbase, int N, int h, int dir, int v, float cd) {
    float S[8];
#pragma unroll
    for (int e = 0; e < 8; ++e) S[e] = 0.f;
    for (int n0 = 0; n0 < N; n0 += 16) {
        v4u L[16];
#pragma unroll
        for (int k = 0; k < 16; ++k) { const int n = n0 + k, c = dir ? (N - 1 - n) : n; L[k] = *(const v4u*)(ST + ((size_t)((cbase + c) * 4 + h)) * 16384 + dir * 8192 + v * 8); }
        asm volatile("s_waitcnt vmcnt(0)" ::: "memory");
#pragma unroll
        for (int k = 0; k < 16; ++k) { const int n = n0 + k, c = dir ? (N - 1 - n) : n;
            v4u o; o.x = pk2(S[0], S[1]); o.y = pk2(S[2], S[3]); o.z = pk2(S[4], S[5]); o.w = pk2(S[6], S[7]);
            *(v4u*)(ST + ((size_t)((cbase + c) * 4 + h)) * 16384 + dir * 8192 + v * 8) = o;
            S[0] = S[0] * cd + bfl(L[k].x); S[1] = S[1] * cd + bfh(L[k].x); S[2] = S[2] * cd + bfl(L[k].y); S[3] = S[3] * cd + bfh(L[k].y);
            S[4] = S[4] * cd + bfl(L[k].z); S[5] = S[5] * cd + bfh(L[k].z); S[6] = S[6] * cd + bfl(L[k].w); S[7] = S[7] * cd + bfh(L[k].w); }
    }
}
__device__ __forceinline__ void ret_scan(bf16_t* ST, const float* dec_f, const float* dec_b, int G, int bx, int tid) {
    if (tid < 32) {
        for (int task = bx * 32 + tid; task < 8192; task += G * 32) { const int v = task & 1023, dir = (task >> 10) & 1, h = task >> 11;
            const float cd = __builtin_amdgcn_exp2f(128.f * log2_gamma(dir ? dec_b[h] : dec_f[h])); ret_chain(ST, 0, 128, h, dir, v, cd); }
    } else if (tid >= 64 && tid < 320) {
        for (int task = bx * 256 + (tid - 64); task < 65536; task += G * 256) { const int v = task & 1023, dir = (task >> 10) & 1, h = (task >> 11) & 3, sq = task >> 13;
            const float cd = __builtin_amdgcn_exp2f(128.f * log2_gamma(dir ? dec_b[h] : dec_f[h])); ret_chain(ST, 128 + 32 * sq, 32, h, dir, v, cd); }
    }
}

__device__ __forceinline__ void ret_outputs(LAS unsigned char* lds, const bf16_t* RQ, const bf16_t* RK, const bf16_t* RV, bf16_t* RG, const bf16_t* ST, const float* dec_f, const float* dec_b, const float* rnorm, int G, int bx, int tid) {
    LAS bf16_t* QS = (LAS bf16_t*)lds; LAS bf16_t* KS = QS + 128 * 72; LAS bf16_t* VT = KS + 128 * 72; LAS bf16_t* SS = VT + 128 * 136;
    const int lane = tid & 63, w = tid >> 6, fr = lane & 15, fq = lane >> 4;
    for (int it = bx; it < NRET_ITEMS; it += G) {
        const int ng = it >> 2, h = it & 3, row0 = ng * 128;
        const float lgf = log2_gamma(dec_f[h]), lgb = log2_gamma(dec_b[h]);
        v4u qw[2], kw[2], sf[2], sb[2], vw[4];
#pragma unroll
        for (int r = 0; r < 2; ++r) { const int idx = tid + 512 * r, j = idx >> 3, c = idx & 7;
            qw[r] = *(const v4u*)(RQ + (size_t)(row0 + j) * 256 + h * 64 + 8 * c);
            kw[r] = *(const v4u*)(RK + (size_t)(row0 + j) * 256 + h * 64 + 8 * c);
            sf[r] = *(const v4u*)(ST + (size_t)it * 16384 + j * 64 + 8 * c);
            sb[r] = *(const v4u*)(ST + (size_t)it * 16384 + 8192 + j * 64 + 8 * c); }
#pragma unroll
        for (int r = 0; r < 4; ++r) { const int idx = tid + 512 * r, j = idx & 127, ec = idx >> 7; vw[r] = *(const v4u*)(RV + (size_t)(row0 + j) * 512 + h * 128 + 8 * ec); }
#pragma unroll
        for (int r = 0; r < 2; ++r) { const int idx = tid + 512 * r, j = idx >> 3, c = idx & 7;
            *(LAS v4u*)(QS + j * 72 + 8 * c) = qw[r]; *(LAS v4u*)(KS + j * 72 + 8 * c) = kw[r];
            *(LAS v4u*)(SS + j * 72 + 8 * c) = sf[r]; *(LAS v4u*)(SS + 128 * 72 + j * 72 + 8 * c) = sb[r]; }
#pragma unroll
        for (int r = 0; r < 4; ++r) { const int idx = tid + 512 * r, j = idx & 127, ec = idx >> 7;
            const v4u wv = vw[r];
            const unsigned ww[4] = {wv.x, wv.y, wv.z, wv.w};
#pragma unroll
            for (int i = 0; i < 4; ++i) { VT[(8 * ec + 2 * i) * 136 + j] = (bf16_t)(ww[i] & 0xffffu); VT[(8 * ec + 2 * i + 1) * 136 + j] = (bf16_t)(ww[i] >> 16); } }
        __syncthreads();
        const int i0 = 16 * w, il = i0 + fr;
        bf16x8 qf[2];
#pragma unroll
        for (int s = 0; s < 2; ++s) qf[s] = *(const LAS bf16x8*)(QS + il * 72 + 32 * s + 8 * fq);
        f32x4 pt[8];
#pragma unroll
        for (int jb = 0; jb < 8; ++jb) { pt[jb] = (f32x4){0.f, 0.f, 0.f, 0.f};
#pragma unroll
            for (int s = 0; s < 2; ++s) { const bf16x8 kf = *(const LAS bf16x8*)(KS + (16 * jb + fr) * 72 + 32 * s + 8 * fq); pt[jb] = mfma16(kf, qf[s], pt[jb]); }
#pragma unroll
            for (int r = 0; r < 4; ++r) { const int j = 16 * jb + 4 * fq + r, diff = il - j;
                const float f = diff >= 0 ? __builtin_amdgcn_exp2f((float)diff * lgf) : __builtin_amdgcn_exp2f((float)(-diff) * lgb); pt[jb][r] *= f; } }
        bf16x8 pf[4];
#pragma unroll
        for (int s2 = 0; s2 < 4; ++s2) { v4u p; p.x = pk2(pt[2 * s2][0], pt[2 * s2][1]); p.y = pk2(pt[2 * s2][2], pt[2 * s2][3]); p.z = pk2(pt[2 * s2 + 1][0], pt[2 * s2 + 1][1]); p.w = pk2(pt[2 * s2 + 1][2], pt[2 * s2 + 1][3]);
            pf[s2] = __builtin_bit_cast(bf16x8, p); }
        f32x4 o[8];
        const float cf = __builtin_amdgcn_exp2f((float)(il + 1) * lgf), cb = __builtin_amdgcn_exp2f((float)(128 - il) * lgb);
#pragma unroll
        for (int eb = 0; eb < 8; ++eb) { o[eb] = (f32x4){0.f, 0.f, 0.f, 0.f};
#pragma unroll
            for (int s2 = 0; s2 < 4; ++s2) { const s16x4 lo = *(const LAS s16x4*)(VT + (16 * eb + fr) * 136 + 32 * s2 + 4 * fq), hi = *(const LAS s16x4*)(VT + (16 * eb + fr) * 136 + 32 * s2 + 16 + 4 * fq);
                const bf16x8 vf = __builtin_shufflevector(lo, hi, 0, 1, 2, 3, 4, 5, 6, 7); o[eb] = mfma16(vf, pf[s2], o[eb]); }
            f32x4 tf = (f32x4){0.f, 0.f, 0.f, 0.f}, tb = tf;
#pragma unroll
            for (int s = 0; s < 2; ++s) { const bf16x8 sf = *(const LAS bf16x8*)(SS + (16 * eb + fr) * 72 + 32 * s + 8 * fq), sb = *(const LAS bf16x8*)(SS + 128 * 72 + (16 * eb + fr) * 72 + 32 * s + 8 * fq);
                tf = mfma16(sf, qf[s], tf); tb = mfma16(sb, qf[s], tb); }
            o[eb] = o[eb] + tf * cf + tb * cb; }
        float sum = 0.f;
#pragma unroll
        for (int eb = 0; eb < 8; ++eb) sum += (o[eb][0] + o[eb][1]) + (o[eb][2] + o[eb][3]);
        sum += __shfl_xor(sum, 16); sum += __shfl_xor(sum, 32);
        const float mu = sum * (1.0f / 128.0f); float q = 0.f;
#pragma unroll
        for (int eb = 0; eb < 8; ++eb) { const f32x4 d = o[eb] - mu; q += (d[0] * d[0] + d[1] * d[1]) + (d[2] * d[2] + d[3] * d[3]); }
        q += __shfl_xor(q, 16); q += __shfl_xor(q, 32);
        const float rstd = 1.0f / sqrtf(q * (1.0f / 128.0f) + NORM_EPS);
        bf16_t* gp = RG + (size_t)(row0 + il) * 512 + h * 128 + 4 * fq;
#pragma unroll
        for (int eb = 0; eb < 8; ++eb) { const v2u gw = *(const v2u*)(gp + 16 * eb); const f32x4 rn = *(const f32x4*)(rnorm + h * 128 + 16 * eb + 4 * fq);
            const f32x4 y = (o[eb] - mu) * rstd * rn;
            v2u ow; ow.x = pk2(pg8::silu_f(bfl(gw.x)) * y[0], pg8::silu_f(bfh(gw.x)) * y[1]); ow.y = pk2(pg8::silu_f(bfl(gw.y)) * y[2], pg8::silu_f(bfh(gw.y)) * y[3]);
            *(v2u*)(gp + 16 * eb) = ow; }
        __syncthreads();
    }
}

__device__ __forceinline__ bool attn_unit_of(int G, int bx, int i, long& rowbase, int& T, int& h, int& qb) {
    if (G == 256) {
        if (i >= 6) return false;
        const int x = bx & 7, c = bx >> 3;
        if (i < 2) { rowbase = 0; T = PROMPT_ROWS; h = x; qb = 2 * c + i; }
        else { const int u = 4 * c + (i - 2); rowbase = PROMPT_ROWS + (long)x * 4096; T = 4096; h = u >> 4; qb = u & 15; }
        return true;
    }
    const int u = bx + i * G; if (u >= 1536) return false;
    if (u < 512) { rowbase = 0; T = PROMPT_ROWS; h = u >> 6; qb = u & 63; }
    else { const int v = u - 512, sq = v >> 7, w = v & 127; rowbase = PROMPT_ROWS + (long)sq * 4096; T = 4096; h = w >> 4; qb = w & 15; }
    return true;
}

__global__ void __launch_bounds__(NTHREADS, 2) fwd_kernel(Args args) {
    extern __shared__ __attribute__((aligned(16))) unsigned char lds_raw[];
    cg::grid_group grid = cg::this_grid();
    if (threadIdx.x < 64) ((LAS unsigned*)lds_raw)[LDS_MISC / 4 + threadIdx.x] = 0u;
    __syncthreads();
    typedef const __attribute__((address_space(4))) Args* KArgs;
    KArgs ka = (KArgs)__builtin_amdgcn_kernarg_segment_ptr();
#if MULTI_LAUNCH
    const int ph_lo = ka->ph_lo, ph_hi = ka->ph_hi;
#else
    constexpr int ph_lo = 0, ph_hi = NPHASE;
#endif

#ifdef DUP_MASK
    for (int step = 2 * ph_lo; step < 2 * ph_hi; ++step) {
        const int ph = step >> 1; const bool dry = !(step & 1);
        { int dsub = -1; if (ph >= 1 && ph < NPHASE - 1) { const int q = (ph - 1) % 10; dsub = q < 2 ? q + 1 : q < 8 ? q + 2 : q + 3; }
          if (dry && !(dsub >= 0 && ((DUP_MASK >> dsub) & 1))) continue; }
#else
    for (int ph = ph_lo; ph < ph_hi; ++ph) {
        const bool dry = false;
#endif
        asm volatile("" : "+s"(ka) :: "memory");
        const int tid = pg8::opaque_tid(), lane = tid & 63, wave = __builtin_amdgcn_readfirstlane(tid >> 6);
        int G = gridDim.x, bx = blockIdx.x; asm volatile("" : "+s"(G), "+s"(bx));
        const int gw = bx * NWAVES + wave, NGW = G * NWAVES;
        LAS unsigned char* lds = (LAS unsigned char*)lds_raw;
#define AIN(k) ((const float*)ka->in[k])
        unsigned char* const ws = ka->ws;
        float* const X = ka->out;
#define XN ((bf16_t*)(ws + WS_XN))
#define HB ((bf16_t*)(ws + WS_HB))
#define Qb ((bf16_t*)(ws + WS_Q))
#define Kb ((bf16_t*)(ws + WS_K))
#define Vb ((bf16_t*)(ws + WS_V))
#define RQ ((bf16_t*)(ws + WS_RQ))
#define RK ((bf16_t*)(ws + WS_RK))
#define RV ((bf16_t*)(ws + WS_RV))
#define RG ((bf16_t*)(ws + WS_RG))
#define Tb ((bf16_t*)(ws + WS_T))
#define Ub ((bf16_t*)(ws + WS_U))
#define ST ((bf16_t*)(ws + WS_ST))
#define SSF ((float*)(ws + WS_SS))
        const bool is_layer = (ph >= 1 && ph < NPHASE - 1);
        const int l = is_layer ? (ph - 1) / 11 : 0, s11 = is_layer ? (ph - 1) % 11 : -1;
        const int sub = !is_layer ? -1 : (int)((0xCB9D8765421ull >> (4 * s11)) & 15ull);
        bf16_t* const WB = (bf16_t*)(ws + ((l & 1) ? WS_WB1 : WS_WB));
        if (ph == 0) {
            for (int m = gw; m < M_TOK; m += 2 * NGW) {
                const int m2 = m + NGW; const bool two = m2 < M_TOK; const int mb = two ? m2 : m;
                const f32x4* xa = (const f32x4*)(m < PROMPT_ROWS ? AIN(0) + (size_t)m * DMODEL : AIN(1) + (size_t)(m - PROMPT_ROWS) * DMODEL) + lane;
                const f32x4* xb = (const f32x4*)(mb < PROMPT_ROWS ? AIN(0) + (size_t)mb * DMODEL : AIN(1) + (size_t)(mb - PROMPT_ROWS) * DMODEL) + lane;
                f32x4 va[4], vb[4];
#pragma unroll
                for (int j = 0; j < 4; ++j) { va[j] = xa[64 * j]; vb[j] = xb[64 * j]; }
                v2u* ba = (v2u*)(XN + (size_t)m * DMODEL) + lane; v2u* bb = (v2u*)(XN + (size_t)mb * DMODEL) + lane;
                float sa = 0.f, sb = 0.f;
#pragma unroll
                for (int j = 0; j < 4; ++j) { v2u w; w.x = pk2(va[j].x, va[j].y); w.y = pk2(va[j].z, va[j].w); ba[64 * j] = w; sa += (va[j].x * va[j].x + va[j].y * va[j].y) + (va[j].z * va[j].z + va[j].w * va[j].w);
                    if (two) { v2u u; u.x = pk2(vb[j].x, vb[j].y); u.y = pk2(vb[j].z, vb[j].w); bb[64 * j] = u; } sb += (vb[j].x * vb[j].x + vb[j].y * vb[j].y) + (vb[j].z * vb[j].z + vb[j].w * vb[j].w); }
                sa = wave_sum(sa); sb = wave_sum(sb);
                if (lane < 16) { SSF[(size_t)m * 16 + lane] = (lane == 0) ? sa : 0.f; if (two) SSF[(size_t)m2 * 16 + lane] = (lane == 0) ? sb : 0.f; }
            }
            if (bx == 0) for (int i = tid; i < XCD_BAR_WORDS; i += NTHREADS) ((unsigned*)(ws + WS_BAR))[i] = 0u;
        } else if (ph == NPHASE - 1) {
            for (int m = gw; m < M_TOK; m += 2 * NGW) {
                final_row(XN + (size_t)m * DMODEL, SSF + (size_t)m * 16, AIN(20), X + (size_t)m * DMODEL, lane);
                if (m + NGW < M_TOK) final_row(XN + (size_t)(m + NGW) * DMODEL, SSF + (size_t)(m + NGW) * 16, AIN(20), X + (size_t)(m + NGW) * DMODEL, lane);
            }
        }
        if (sub == 6) ret_scan(ST, AIN(9) + l * 4, AIN(10) + l * 4, G, bx, tid);
        if (ph == 0 || (sub == 6 && l + 1 < DEPTH)) {
            const int cl = (ph == 0) ? 0 : l + 1;
            bf16_t* const WD = (bf16_t*)(ws + ((cl & 1) ? WS_WB1 : WS_WB));
            LAS float* scr = (LAS float*)(lds + wave * 16384);
            constexpr int I0 = 16 * 176, I1 = 44 * 32, I2 = 16 * 72, I3 = 16 * 64, I4 = 8 * 32, I5 = 8 * 32, I6 = 16 * 32, I7 = 16 * 176, I8 = 44 * 32;
            constexpr int NITEMS = I0 + I1 + I2 + I3 + I4 + I5 + I6 + I7 + I8;
            const int cw0 = (ph == 0) ? gw : bx * (NWAVES - 1) + wave - 1, cnw = (ph == 0) ? NGW : G * (NWAVES - 1);
            for (int it = (ph != 0 && wave == 0) ? NITEMS : cw0; it < NITEMS; it += cnw) {
                int r = it;
                if (r < I0) { transpose_item(AIN(3) + (size_t)cl * 1024 * 5632, AIN(2) + cl * 1024, 1024, 5632, WD + OW13A, 1, scr, r, lane); continue; } r -= I0;
                if (r < I1) { transpose_item(AIN(4) + (size_t)cl * 2816 * 1024, nullptr, 2816, 1024, WD + OW2A, 0, scr, r, lane); continue; } r -= I1;
                if (r < I2) { transpose_item(AIN(6) + (size_t)cl * 1024 * 2304, AIN(5) + cl * 1024, 1024, 2304, WD + OWIN, 2, scr, r, lane); continue; } r -= I2;
                if (r < I3) { transpose_item(AIN(14) + (size_t)cl * 1024 * 2048, AIN(5) + cl * 1024, 1024, 2048, WD + OWG, 3, scr, r, lane); continue; } r -= I3;
                if (r < I4) { transpose_item(AIN(12) + (size_t)cl * 512 * 1024, nullptr, 512, 1024, WD + OWBA, 0, scr, r, lane); continue; } r -= I4;
                if (r < I5) { transpose_item(AIN(13) + (size_t)cl * 512 * 1024, nullptr, 512, 1024, WD + OWBR, 0, scr, r, lane); continue; } r -= I5;
                if (r < I6) { transpose_item(AIN(16) + (size_t)cl * 1024 * 1024, nullptr, 1024, 1024, WD + OWO, 0, scr, r, lane); continue; } r -= I6;
                if (r < I7) { transpose_item(AIN(18) + (size_t)cl * 1024 * 5632, AIN(17) + cl * 1024, 1024, 5632, WD + OW13B, 1, scr, r, lane); continue; } r -= I7;
                transpose_item(AIN(19) + (size_t)cl * 2816 * 1024, nullptr, 2816, 1024, WD + OW2B, 0, scr, r, lane);
            }
            asm volatile("s_waitcnt vmcnt(0) lgkmcnt(0)" ::: "memory"); __syncthreads();
        }
        if (is_layer) {
            if (sub == 5) {
                long rowbase; int T, h, qb;
#ifndef NO_ATTN
                for (int i = 0; attn_unit_of(G, bx, i, rowbase, T, h, qb); ++i)
                    attn_body::attn_unit<8>(rowbase, T, h, qb, (const attn_body::bf16*)Qb, (const attn_body::bf16*)Kb, (const attn_body::bf16*)Vb, (attn_body::bf16*)(dry ? Tb : Qb), (char*)lds_raw);
#endif
                __syncthreads();
                ret_local_states(lds, RK, RV, ST, AIN(9) + l * 4, AIN(10) + l * 4, G, bx, tid);
            }
            if (sub == 7) ret_outputs(lds, RQ, RK, RV, RG, ST, AIN(9) + l * 4, AIN(10) + l * 4, AIN(11) + l * 512, G, bx, tid);
            if (sub == 6 || sub == 7) { asm volatile("s_waitcnt vmcnt(0) lgkmcnt(0)" ::: "memory"); __syncthreads(); }
#ifndef NO_G1
            if (sub == 1 || sub == 11) {
                pg8::Gemm g{XN, WB + (sub == 1 ? OW13A : OW13B), M_TOK, 2 * DFF, DMODEL}; pg8::StaticOrder S; S.init(M_TOK, 2 * DFF, G, bx);
                pg8::EpiSwiglu E{HB, DFF, SSF};
                pg8::gemm_phase<pg8::EpiSwiglu, pg8::StaticOrder, true, true>(lds, g, S, E);
            }
#endif
#ifndef NO_G2
            if (sub == 2 || sub == 12 || sub == 9) {
                pg8::Gemm g{sub == 9 ? Tb : HB, WB + (sub == 2 ? OW2A : sub == 12 ? OW2B : OWO), M_TOK, DMODEL, sub == 9 ? DMODEL : DFF}; pg8::StaticOrder S; S.init(M_TOK, DMODEL, G, bx);
                const bool first = (l == 0 && sub == 2);
                pg8::EpiResid E{XN, first ? AIN(0) : (const float*)nullptr, first ? AIN(1) - (size_t)PROMPT_ROWS * DMODEL : (const float*)nullptr, SSF, sub == 9 ? 1.0f : 0.5f};
                pg8::gemm_phase<pg8::EpiResid, pg8::StaticOrder, false, true>(lds, g, S, E);
            }
#endif
#ifndef NO_G3
            if (sub == 4) {
                pg8::Gemm g{XN, WB + OWIN, M_TOK, NPROJ, DMODEL}; pg8::StaticOrder S; S.init(M_TOK, NPROJ, G, bx);
                pg8::EpiInProj E{(bf16_t*)(ws + WS_B), AIN(7) + l * 64, AIN(8) + l * 64, SSF, ATT_C2};
                pg8::gemm_phase<pg8::EpiInProj, pg8::StaticOrder, true, true>(lds, g, S, E);
            }
#endif
#ifndef NO_G4
            if (sub == 6 || sub == 8 || sub == 13) {
                const int mode = (sub == 6) ? 0 : (sub == 8) ? 5 : 4;
                const bf16_t* A = (mode == 0) ? Qb : (mode == 5) ? RG : XN;
                const bf16_t* Bt = WB + ((mode == 0) ? OWBA : (mode == 5) ? OWBR : OWG);
                const int Ng = (mode == 4) ? 2 * DMODEL : DMODEL;
                pg8::Gemm g{A, Bt, M_TOK, Ng, (mode == 4) ? DMODEL : 512}; pg8::StaticOrder S; S.init(M_TOK, Ng, G, bx);
                pg8::EpiMix E{Tb, Ub, AIN(15) + (size_t)l * 2048, SSF, mode};
                pg8::gemm_phase<pg8::EpiMix, pg8::StaticOrder, true, true>(lds, g, S, E);
            }
#endif
        }
#ifdef DUP_MASK
        if (step + 1 < 2 * ph_hi) grid.sync();
#else
        if (ph + 1 < ph_hi) {
            unsigned* const barw = (unsigned*)(ka->ws + WS_BAR);
            if (ph == 0) { grid.sync();
                if (threadIdx.x == 0) (void)xb_add(&barw[XB_XCNT(xb_xcc_id())], 1u); }
            else { XcdBarrier b; b.bar = barw; b.x = xb_xcc_id(); b.st = (volatile LAS unsigned*)((LAS unsigned char*)lds_raw + LDS_MISC + 32); xcd_barrier(b); }
        }
#endif
    }
#ifdef EXTRA_SYNCS
    for (int i = 0; i < EXTRA_SYNCS; ++i) grid.sync();
#endif
}

extern "C" void kernel_launch(void* const* d_in, const int* in_sizes, int n_in, void* d_out, int out_size, void* d_ws, size_t ws_size, hipStream_t stream) {
    static int grid = 0;
    if (grid == 0) {
        if (n_in != 21 || out_size != M_TOK * DMODEL || ws_size < WS_END) { fprintf(stderr, "kernel_launch: unexpected shapes: n_in %d out %d ws %zu (need %zu)\n", n_in, out_size, ws_size, (size_t)WS_END); grid = -1; return; }
        int dev = 0, cus = 0, per_cu = 0;
        if (hipGetDevice(&dev) != hipSuccess || hipDeviceGetAttribute(&cus, hipDeviceAttributeMultiprocessorCount, dev) != hipSuccess) { grid = -1; return; }
        if (hipFuncSetAttribute((const void*)fwd_kernel, hipFuncAttributeMaxDynamicSharedMemorySize, LDS_BYTES) != hipSuccess) { fprintf(stderr, "kernel_launch: hipFuncSetAttribute failed\n"); grid = -1; return; }
        if (hipOccupancyMaxActiveBlocksPerMultiprocessor(&per_cu, (const void*)fwd_kernel, NTHREADS, LDS_BYTES) != hipSuccess || per_cu < 1) { fprintf(stderr, "kernel_launch: occupancy query says %d\n", per_cu); per_cu = 1; }
        (void)hipGetLastError();
        grid = cus * per_cu;
    }
    if (grid < 0) return;
    Args a{};
    for (int i = 0; i < 21; ++i) a.in[i] = (const float*)d_in[i];
    a.out = (float*)d_out; a.ws = (unsigned char*)d_ws;
#if MULTI_LAUNCH
    for (int ph = 0; ph < NPHASE; ++ph) {
        a.ph_lo = ph; a.ph_hi = ph + 1;
        hipLaunchKernelGGL(fwd_kernel, dim3(grid), dim3(NTHREADS), LDS_BYTES, stream, a);
    }
#else
    a.ph_lo = 0; a.ph_hi = NPHASE;
    void* kargs[] = {&a};
    hipError_t e = hipLaunchCooperativeKernel((const void*)fwd_kernel, dim3(grid), dim3(NTHREADS), kargs, LDS_BYTES, stream);
    if (e != hipSuccess) fprintf(stderr, "kernel_launch: cooperative launch failed: %s (grid %d)\n", hipGetErrorString(e), grid);
#endif
}
```

```cpp
#include <hip/hip_runtime.h>
#include <hip/hip_cooperative_groups.h>
#include <cstdio>
#include <cstdint>
namespace cg = cooperative_groups;
#define MULTI_LAUNCH 0
namespace pg8 {
#define PG8_LAS __attribute__((address_space(3)))
typedef unsigned short bf16_t;
typedef short bf16x8 __attribute__((ext_vector_type(8)));
typedef float f32x4 __attribute__((ext_vector_type(4)));
typedef unsigned u32x4 __attribute__((ext_vector_type(4)));
constexpr int BM = 256, BK = 64, HALF = 128, HTB = HALF * BK * 2  , STAGE_BYTES = 8 * HTB, NXCD = 8, WGM = 8;

__host__ __device__ __forceinline__ int lds_byte(int r, int c) { const int st = (r >> 4) * 2 + (c >> 5), rr = r & 15, cc = c & 31, ob = rr * 64 + cc * 2; return st * 1024 + (ob ^ (((ob >> 9) & 1) << 5)); }
__host__ __device__ __forceinline__ void stage_rc(int b, int& R, int& C) { const int st = b / 1024, sb = b % 1024, swz = sb ^ (((sb >> 9) & 1) << 5); R = (st >> 1) * 16 + swz / 64; C = (st & 1) * 32 + (swz % 64) / 2; }
__host__ __device__ __forceinline__ int perm32(int rho) { const int n = rho >> 4, i = rho & 15; return 8 * (i >> 2) + 4 * n + (i & 3); }

struct Unit { int pm, pn; };
struct Gemm { const bf16_t* A; const bf16_t* Bt; int M, N, K; };

struct StaticOrder {
    int nM, nN, nwg, G, c;
    __host__ __device__ void init(int M, int N, int G_, int c_) { nM = M / BM; nN = N / BM; nwg = nM * nN; G = G_; c = c_; }
    __host__ __device__ bool next(int i, Unit& u) const {
        const long L = (long)i * G + c; if (L >= nwg) return false;
        int wgid = (int)L; { const int q = nwg / NXCD, r = nwg % NXCD, xcd = wgid % NXCD, off = wgid / NXCD; wgid = (xcd < r ? xcd * (q + 1) : r * (q + 1) + (xcd - r) * q) + off; }
        const int nig = WGM * nN, gid = wgid / nig, fm = gid * WGM, gsz = (nM - fm) < WGM ? (nM - fm) : WGM;
        u.pm = fm + ((wgid % nig) % gsz); u.pn = (wgid % nig) / gsz; return true;
    }
    __device__ __forceinline__ void a_ready(const Unit&) const {}
    __device__ __forceinline__ void done(const Unit&) const {}
};

typedef float f32x2 __attribute__((ext_vector_type(2)));
typedef __bf16 bf16x2_cv __attribute__((ext_vector_type(2)));
__device__ __forceinline__ unsigned cvt_pk_bf16(float lo, float hi) { f32x2 v = {lo, hi}; bf16x2_cv b = __builtin_convertvector(v, bf16x2_cv); return __builtin_bit_cast(unsigned, b); }
typedef _Float16 f16x2_cv __attribute__((ext_vector_type(2)));
typedef _Float16 f16x8_cv __attribute__((ext_vector_type(8)));
__device__ __forceinline__ unsigned cvt_pk_f16(float lo, float hi) { f32x2 v = {lo, hi}; f16x2_cv h = __builtin_convertvector(v, f16x2_cv); return __builtin_bit_cast(unsigned, h); }
__device__ __forceinline__ f32x2 cvt_f16_pair(unsigned w) { return __builtin_convertvector(__builtin_bit_cast(f16x2_cv, w), f32x2); }
template <bool F16> __device__ __forceinline__ f32x4 mma16(bf16x8 a, bf16x8 b, f32x4 c) {
    if constexpr (F16) return __builtin_amdgcn_mfma_f32_16x16x32_f16(__builtin_bit_cast(f16x8_cv, a), __builtin_bit_cast(f16x8_cv, b), c, 0, 0, 0);
    else return __builtin_amdgcn_mfma_f32_16x16x32_bf16(a, b, c, 0, 0, 0);
}
typedef unsigned u32x2 __attribute__((ext_vector_type(2)));
__device__ __forceinline__ int opaque_tid() { int t = threadIdx.x; asm volatile("" : "+v"(t)); return t; }
__device__ __forceinline__ float bf_lo(unsigned w) { return __uint_as_float(w << 16); }
__device__ __forceinline__ float bf_hi(unsigned w) { return __uint_as_float(w & 0xffff0000u); }
__device__ __forceinline__ float sigmoid_f(float v) { return __builtin_amdgcn_rcpf(1.f + __builtin_amdgcn_exp2f(-1.4426950408889634f * v)); }
__device__ __forceinline__ float silu_f(float v) { return v * sigmoid_f(v); }
__device__ __forceinline__ void rows_rstd(const float* SS, int row0, int fq, float (&rstd)[8]) {
    f32x4 pr[8];
#pragma unroll
    for (int k = 0; k < 8; ++k) pr[k] = *(const f32x4*)(SS + (size_t)(row0 + (k >> 2) * HALF + (k & 3) * 16) * 16 + 4 * fq);
#pragma unroll
    for (int k = 0; k < 8; ++k) { float s = (pr[k][0] + pr[k][1]) + (pr[k][2] + pr[k][3]); s += __shfl_xor(s, 16); s += __shfl_xor(s, 32); rstd[k] = __builtin_amdgcn_rsqf(s * (1.0f / 1024.0f) + 1e-6f); }
}

__device__ __forceinline__ void unpack8(const u32x4 w, f32x4& lo, f32x4& hi) { lo[0] = bf_lo(w.x); lo[1] = bf_hi(w.x); lo[2] = bf_lo(w.y); lo[3] = bf_hi(w.y); hi[0] = bf_lo(w.z); hi[1] = bf_hi(w.z); hi[2] = bf_lo(w.w); hi[3] = bf_hi(w.w); }
__device__ __forceinline__ u32x4 pack8(const f32x4 a, const f32x4 b) { u32x4 w; w.x = cvt_pk_bf16(a[0], a[1]); w.y = cvt_pk_bf16(a[2], a[3]); w.z = cvt_pk_bf16(b[0], b[1]); w.w = cvt_pk_bf16(b[2], b[3]); return w; }
struct EpiSwiglu {
    static constexpr bool PERM = true, AFTER_DRAIN = false;
    bf16_t* H; int ldh; const float* SS;
    __device__ __forceinline__ void operator()(const f32x4 (&acc)[2][2][4][2], const Unit& u, int wr, int wc, int fr, int fq) const {
        const int row0 = u.pm * BM + wr * 64 + fr, col0 = u.pn * HALF + wc * 32 + 8 * fq;
        float rstd[8]; rows_rstd(SS, row0, fq, rstd);
#pragma unroll
        for (int ai = 0; ai < 2; ++ai)
#pragma unroll
            for (int m = 0; m < 4; ++m) {
                bf16_t* p = H + (size_t)(row0 + ai * HALF + m * 16) * ldh + col0;
                const float rs = rstd[ai * 4 + m], nrs = -1.4426950408889634f * rs, rs2 = rs * rs;
                const f32x4 a0 = acc[ai][0][m][0], a1 = acc[ai][0][m][1], b0 = acc[ai][1][m][0], b1 = acc[ai][1][m][1];
                const f32x4 t0 = a0 * nrs, t1 = a1 * nrs;
                f32x4 e0, e1;
                e0[0] = __builtin_amdgcn_exp2f(t0[0]); e0[1] = __builtin_amdgcn_exp2f(t0[1]); e0[2] = __builtin_amdgcn_exp2f(t0[2]); e0[3] = __builtin_amdgcn_exp2f(t0[3]);
                e1[0] = __builtin_amdgcn_exp2f(t1[0]); e1[1] = __builtin_amdgcn_exp2f(t1[1]); e1[2] = __builtin_amdgcn_exp2f(t1[2]); e1[3] = __builtin_amdgcn_exp2f(t1[3]);
                const f32x4 d0 = e0 + 1.0f, d1 = e1 + 1.0f, ab0 = a0 * b0, ab1 = a1 * b1;
                f32x4 r0, r1;
                r0[0] = __builtin_amdgcn_rcpf(d0[0]); r0[1] = __builtin_amdgcn_rcpf(d0[1]); r0[2] = __builtin_amdgcn_rcpf(d0[2]); r0[3] = __builtin_amdgcn_rcpf(d0[3]);
                r1[0] = __builtin_amdgcn_rcpf(d1[0]); r1[1] = __builtin_amdgcn_rcpf(d1[1]); r1[2] = __builtin_amdgcn_rcpf(d1[2]); r1[3] = __builtin_amdgcn_rcpf(d1[3]);
                const f32x4 h0 = ab0 * (r0 * rs2), h1 = ab1 * (r1 * rs2);
                u32x4 w;
                w.x = cvt_pk_bf16(h0[0], h0[1]); w.y = cvt_pk_bf16(h0[2], h0[3]); w.z = cvt_pk_bf16(h1[0], h1[1]); w.w = cvt_pk_bf16(h1[2], h1[3]);
                *(u32x4*)p = w;
            }
    }
};
struct EpiResid {
    static constexpr bool PERM = true, AFTER_DRAIN = false;
    bf16_t* XH; const float* S0; const float* S1; float* SSo; float s;
    __device__ __forceinline__ void operator()(const f32x4 (&acc)[2][2][4][2], const Unit& u, int wr, int wc, int fr, int fq) const {
        const int row0 = u.pm * BM + wr * 64 + fr, col0 = u.pn * BM + wc * 32 + 8 * fq;
        const bool first = (S0 != nullptr);
        const float* src = (u.pm < 64) ? S0 : S1;
        if (first) {
#pragma unroll
            for (int ai = 0; ai < 2; ++ai) {
                f32x4 raw[4][2][2];
#pragma unroll
                for (int m = 0; m < 4; ++m)
#pragma unroll
                    for (int bj = 0; bj < 2; ++bj) { const float* p = src + (size_t)(row0 + ai * HALF + m * 16) * 1024 + col0 + bj * HALF; raw[m][bj][0] = __builtin_nontemporal_load((const f32x4*)p); raw[m][bj][1] = __builtin_nontemporal_load((const f32x4*)(p + 4)); }
                asm volatile("" ::: "memory");
#pragma unroll
                for (int m = 0; m < 4; ++m) {
                    float ss = 0.f;
#pragma unroll
                    for (int bj = 0; bj < 2; ++bj) {
                        const f32x4 o0 = raw[m][bj][0] + acc[ai][bj][m][0] * s, o1 = raw[m][bj][1] + acc[ai][bj][m][1] * s;
                        const f32x4 q = o0 * o0 + o1 * o1; ss += (q[0] + q[1]) + (q[2] + q[3]);
                        *(u32x4*)(XH + (size_t)(row0 + ai * HALF + m * 16) * 1024 + col0 + bj * HALF) = pack8(o0, o1);
                    }
                    ss += __shfl_xor(ss, 16); ss += __shfl_xor(ss, 32);
                    if (fq == 0) SSo[(size_t)(row0 + ai * HALF + m * 16) * 16 + u.pn * 4 + wc] = ss;
                }
                asm volatile("" ::: "memory");
            }
        } else {
#pragma unroll
            for (int ai = 0; ai < 2; ++ai) {
                u32x4 raw[4][2];
#pragma unroll
                for (int m = 0; m < 4; ++m)
#pragma unroll
                    for (int bj = 0; bj < 2; ++bj) raw[m][bj] = *(const u32x4*)(XH + (size_t)(row0 + ai * HALF + m * 16) * 1024 + col0 + bj * HALF);
                asm volatile("" ::: "memory");
#pragma unroll
                for (int m = 0; m < 4; ++m) {
                    float ss = 0.f;
#pragma unroll
                    for (int bj = 0; bj < 2; ++bj) {
                        f32x4 x0, x1; unpack8(raw[m][bj], x0, x1);
                        const f32x4 o0 = x0 + acc[ai][bj][m][0] * s, o1 = x1 + acc[ai][bj][m][1] * s;
                        const f32x4 q = o0 * o0 + o1 * o1; ss += (q[0] + q[1]) + (q[2] + q[3]);
                        *(u32x4*)(XH + (size_t)(row0 + ai * HALF + m * 16) * 1024 + col0 + bj * HALF) = pack8(o0, o1);
                    }
                    ss += __shfl_xor(ss, 16); ss += __shfl_xor(ss, 32);
                    if (fq == 0) SSo[(size_t)(row0 + ai * HALF + m * 16) * 16 + u.pn * 4 + wc] = ss;
                }
                asm volatile("" ::: "memory");
            }
        }
    }
};
__device__ __forceinline__ void sigmoid8(f32x4& v0, f32x4& v1) {
    const f32x4 t0 = v0 * -1.4426950408889634f, t1 = v1 * -1.4426950408889634f; f32x4 e0, e1;
    e0[0] = __builtin_amdgcn_exp2f(t0[0]); e0[1] = __builtin_amdgcn_exp2f(t0[1]); e0[2] = __builtin_amdgcn_exp2f(t0[2]); e0[3] = __builtin_amdgcn_exp2f(t0[3]);
    e1[0] = __builtin_amdgcn_exp2f(t1[0]); e1[1] = __builtin_amdgcn_exp2f(t1[1]); e1[2] = __builtin_amdgcn_exp2f(t1[2]); e1[3] = __builtin_amdgcn_exp2f(t1[3]);
    const f32x4 d0 = e0 + 1.0f, d1 = e1 + 1.0f;
    v0[0] = __builtin_amdgcn_rcpf(d0[0]); v0[1] = __builtin_amdgcn_rcpf(d0[1]); v0[2] = __builtin_amdgcn_rcpf(d0[2]); v0[3] = __builtin_amdgcn_rcpf(d0[3]);
    v1[0] = __builtin_amdgcn_rcpf(d1[0]); v1[1] = __builtin_amdgcn_rcpf(d1[1]); v1[2] = __builtin_amdgcn_rcpf(d1[2]); v1[3] = __builtin_amdgcn_rcpf(d1[3]);
}
struct EpiMix {
    static constexpr bool PERM = true, AFTER_DRAIN = false;
    bf16_t* T; bf16_t* U; const float* bias; const float* SS; int mode;
    template <int MODE> __device__ __forceinline__ void run(const f32x4 (&acc)[2][2][4][2], const Unit& u, int wr, int wc, int fr, int fq) const {
        const int row0 = u.pm * BM + wr * 64 + fr, col0 = u.pn * BM + wc * 32 + 8 * fq;
        float rstd[8];
        if (MODE == 1 || MODE == 2) rows_rstd(SS, row0, fq, rstd);
#pragma unroll
        for (int bj = 0; bj < 2; ++bj) {
            f32x4 bv0 = (f32x4){0.f, 0.f, 0.f, 0.f}, bv1 = bv0;
            if (MODE == 1 || MODE == 2) { bv0 = *(const f32x4*)(bias + col0 + bj * HALF); bv1 = *(const f32x4*)(bias + col0 + bj * HALF + 4); }
#pragma unroll
            for (int ai = 0; ai < 2; ++ai) {
                u32x4 tw[4], uw[4];
                if (MODE == 1 || MODE == 3) {
#pragma unroll
                    for (int m = 0; m < 4; ++m) tw[m] = *(const u32x4*)(T + (size_t)(row0 + ai * HALF + m * 16) * 1024 + col0 + bj * HALF); }
                if (MODE == 3) {
#pragma unroll
                    for (int m = 0; m < 4; ++m) uw[m] = *(const u32x4*)(U + (size_t)(row0 + ai * HALF + m * 16) * 1024 + col0 + bj * HALF); }
                asm volatile("" ::: "memory");
#pragma unroll
                for (int m = 0; m < 4; ++m) {
                    const size_t idx = (size_t)(row0 + ai * HALF + m * 16) * 1024 + col0 + bj * HALF;
                    f32x4 v0 = acc[ai][bj][m][0], v1 = acc[ai][bj][m][1];
                    if (MODE == 1 || MODE == 2) { const float rs = rstd[ai * 4 + m]; v0 = v0 * rs + bv0; v1 = v1 * rs + bv1; sigmoid8(v0, v1); }
                    if (MODE == 1) { f32x4 t0, t1; unpack8(tw[m], t0, t1); v0 = v0 * t0; v1 = v1 * t1; }
                    if (MODE == 3) { f32x4 t0, t1, g0, g1; unpack8(tw[m], t0, t1); unpack8(uw[m], g0, g1); v0 = t0 + g0 * v0; v1 = t1 + g1 * v1; }
                    u32x4 w; w.x = cvt_pk_bf16(v0[0], v0[1]); w.y = cvt_pk_bf16(v0[2], v0[3]); w.z = cvt_pk_bf16(v1[0], v1[1]); w.w = cvt_pk_bf16(v1[2], v1[3]);
                    *(u32x4*)(((MODE == 2 || MODE == 5) ? U : T) + idx) = w;
                }
                asm volatile("" ::: "memory");
            }
        }
    }
    __device__ __forceinline__ void run4(const f32x4 (&acc)[2][2][4][2], const Unit& u, int wr, int wc, int fr, int fq) const {
        const int row0 = u.pm * BM + wr * 64 + fr, mcol0 = u.pn * HALF + wc * 32 + 8 * fq;
        float rstd[8]; rows_rstd(SS, row0, fq, rstd);
        const f32x4 ba0 = *(const f32x4*)(bias + mcol0), ba1 = *(const f32x4*)(bias + mcol0 + 4), br0 = *(const f32x4*)(bias + 1024 + mcol0), br1 = *(const f32x4*)(bias + 1024 + mcol0 + 4);
#pragma unroll
        for (int ai = 0; ai < 2; ++ai) {
            u32x4 tw[4], uw[4];
#pragma unroll
            for (int m = 0; m < 4; ++m) { const size_t idx = (size_t)(row0 + ai * HALF + m * 16) * 1024 + mcol0; tw[m] = *(const u32x4*)(T + idx); uw[m] = *(const u32x4*)(U + idx); }
            asm volatile("" ::: "memory");
#pragma unroll
            for (int m = 0; m < 4; ++m) {
                const size_t idx = (size_t)(row0 + ai * HALF + m * 16) * 1024 + mcol0;
                const float rs = rstd[ai * 4 + m];
                f32x4 o0, o1;
                { f32x4 a0 = acc[ai][0][m][0] * rs + ba0, a1 = acc[ai][0][m][1] * rs + ba1; sigmoid8(a0, a1); f32x4 t0, t1; unpack8(tw[m], t0, t1); o0 = a0 * t0; o1 = a1 * t1; }
                asm volatile("" : "+v"(o0), "+v"(o1));
                { f32x4 r0 = acc[ai][1][m][0] * rs + br0, r1 = acc[ai][1][m][1] * rs + br1; sigmoid8(r0, r1); f32x4 g0, g1; unpack8(uw[m], g0, g1); o0 = o0 + r0 * g0; o1 = o1 + r1 * g1; }
                *(u32x4*)(T + idx) = pack8(o0, o1);
            }
            asm volatile("" ::: "memory");
        }
    }
    __device__ __forceinline__ void operator()(const f32x4 (&acc)[2][2][4][2], const Unit& u, int wr, int wc, int fr, int fq) const {
        if (mode == 0) run<0>(acc, u, wr, wc, fr, fq);
        else if (mode == 5) run<5>(acc, u, wr, wc, fr, fq);
        else run4(acc, u, wr, wc, fr, fq);
    }
};
struct EpiInProj {
    static constexpr bool PERM = true, AFTER_DRAIN = false;
    static constexpr size_t EMI = 524288;
    static constexpr size_t EQ = 0, EK = 48 * EMI, EV = 60 * EMI, ERQ = 72 * EMI, ERK = 96 * EMI, ERV = 120 * EMI, ERG = 168 * EMI;
    bf16_t* base; const float *qn, *kn, *SS; float qscale;
    __device__ __forceinline__ void operator()(const f32x4 (&acc)[2][2][4][2], const Unit& u, int wr, int wc, int fr, int fq) const {
        const int pn = u.pn, row0 = u.pm * BM + wr * 64 + fr;
        const bool isq = pn <= 1, isk = (pn == 2 && wc < 2), isv = (pn == 2 && wc >= 2);
        const bool do_norm = isq || isk, do_rope = isq || isk || pn == 3 || pn == 4;
        float g_lo[8], g_hi[8];
#pragma unroll
        for (int e = 0; e < 8; ++e) { g_lo[e] = 1.f; g_hi[e] = 1.f; }
        if (do_norm) { const float* g = isq ? qn : kn;
#pragma unroll
            for (int e = 0; e < 8; ++e) { g_lo[e] = g[8 * fq + e]; g_hi[e] = g[32 + 8 * fq + e]; } }
        const float post = isq ? qscale : (pn == 4 ? 0.125f : 1.f);
        size_t eo; int ld, cb;
        if (isq) { eo = EQ; ld = 512; cb = (4 * pn + wc) * 64; }
        else if (isk) { eo = EK; ld = 128; cb = wc * 64; }
        else if (isv) { eo = EV; ld = 128; cb = (wc - 2) * 64; }
        else if (pn == 3) { eo = ERQ; ld = 256; cb = wc * 64; }
        else if (pn == 4) { eo = ERK; ld = 256; cb = wc * 64; }
        else if (pn <= 6) { eo = ERV; ld = 512; cb = (pn - 5) * 256 + wc * 64; }
        else { eo = ERG; ld = 512; cb = (pn - 7) * 256 + wc * 64; }
        bf16_t* dst = base + eo;
        float rstd[8]; rows_rstd(SS, row0, fq, rstd);
        f32x4 gl0, gl1, gh0, gh1;
#pragma unroll
        for (int e = 0; e < 4; ++e) { gl0[e] = g_lo[e]; gl1[e] = g_lo[4 + e]; gh0[e] = g_hi[e]; gh1[e] = g_hi[4 + e]; }
#pragma unroll
        for (int ai = 0; ai < 2; ++ai)
#pragma unroll
            for (int m = 0; m < 4; ++m) {
                const int row = row0 + ai * HALF + m * 16;
                const float rs = rstd[ai * 4 + m];
                f32x4 lo0 = acc[ai][0][m][0] * rs, lo1 = acc[ai][0][m][1] * rs, hi0 = acc[ai][1][m][0] * rs, hi1 = acc[ai][1][m][1] * rs;
                if (do_norm) {
                    const f32x4 q = lo0 * lo0 + lo1 * lo1 + hi0 * hi0 + hi1 * hi1;
                    float ss = (q[0] + q[1]) + (q[2] + q[3]);
                    ss += __shfl_xor(ss, 16); ss += __shfl_xor(ss, 32);
                    const float hr = __builtin_amdgcn_rsqf(ss * (1.0f / 64.0f) + 1e-6f);
                    lo0 = lo0 * (gl0 * hr); lo1 = lo1 * (gl1 * hr); hi0 = hi0 * (gh0 * hr); hi1 = hi1 * (gh1 * hr);
                }
                if (do_rope) {
                    const int t = row < 16384 ? row : (row & 4095);
                    const float pf = (float)((fq < 2) ? (t >> 6) : (t & 63));
                    int fqo = fq & 1; asm volatile("" : "+v"(fqo));
                    const float fb = (float)(8 * fqo) * (-13.287712379549449f / 16.0f);
                    f32x4 x0, x1;
                    x0[0] = __builtin_amdgcn_exp2f(fb); x0[1] = __builtin_amdgcn_exp2f(fb - 1.0f * (13.287712379549449f / 16.0f)); x0[2] = __builtin_amdgcn_exp2f(fb - 2.0f * (13.287712379549449f / 16.0f)); x0[3] = __builtin_amdgcn_exp2f(fb - 3.0f * (13.287712379549449f / 16.0f));
                    x1[0] = __builtin_amdgcn_exp2f(fb - 4.0f * (13.287712379549449f / 16.0f)); x1[1] = __builtin_amdgcn_exp2f(fb - 5.0f * (13.287712379549449f / 16.0f)); x1[2] = __builtin_amdgcn_exp2f(fb - 6.0f * (13.287712379549449f / 16.0f)); x1[3] = __builtin_amdgcn_exp2f(fb - 7.0f * (13.287712379549449f / 16.0f));
                    x0 = x0 * (pf * 0.15915494309189535f); x1 = x1 * (pf * 0.15915494309189535f);
                    f32x4 r0, r1;
                    r0[0] = __builtin_rintf(x0[0]); r0[1] = __builtin_rintf(x0[1]); r0[2] = __builtin_rintf(x0[2]); r0[3] = __builtin_rintf(x0[3]);
                    r1[0] = __builtin_rintf(x1[0]); r1[1] = __builtin_rintf(x1[1]); r1[2] = __builtin_rintf(x1[2]); r1[3] = __builtin_rintf(x1[3]);
                    x0 = x0 - r0; x1 = x1 - r1;
                    f32x4 c0, c1, s0, s1;
                    c0[0] = __builtin_amdgcn_cosf(x0[0]); c0[1] = __builtin_amdgcn_cosf(x0[1]); c0[2] = __builtin_amdgcn_cosf(x0[2]); c0[3] = __builtin_amdgcn_cosf(x0[3]);
                    c1[0] = __builtin_amdgcn_cosf(x1[0]); c1[1] = __builtin_amdgcn_cosf(x1[1]); c1[2] = __builtin_amdgcn_cosf(x1[2]); c1[3] = __builtin_amdgcn_cosf(x1[3]);
                    s0[0] = __builtin_amdgcn_sinf(x0[0]); s0[1] = __builtin_amdgcn_sinf(x0[1]); s0[2] = __builtin_amdgcn_sinf(x0[2]); s0[3] = __builtin_amdgcn_sinf(x0[3]);
                    s1[0] = __builtin_amdgcn_sinf(x1[0]); s1[1] = __builtin_amdgcn_sinf(x1[1]); s1[2] = __builtin_amdgcn_sinf(x1[2]); s1[3] = __builtin_amdgcn_sinf(x1[3]);
                    const f32x4 a0 = (lo0 * c0 - hi0 * s0) * post, a1 = (lo1 * c1 - hi1 * s1) * post, b0 = (lo0 * s0 + hi0 * c0) * post, b1 = (lo1 * s1 + hi1 * c1) * post;
                    lo0 = a0; lo1 = a1; hi0 = b0; hi1 = b1;
                }
                bf16_t* p = dst + (size_t)row * ld + cb + 8 * fq;
                u32x4 w; w.x = cvt_pk_bf16(lo0[0], lo0[1]); w.y = cvt_pk_bf16(lo0[2], lo0[3]); w.z = cvt_pk_bf16(lo1[0], lo1[1]); w.w = cvt_pk_bf16(lo1[2], lo1[3]);
                *(u32x4*)p = w;
                w.x = cvt_pk_bf16(hi0[0], hi0[1]); w.y = cvt_pk_bf16(hi0[2], hi0[3]); w.z = cvt_pk_bf16(hi1[0], hi1[1]); w.w = cvt_pk_bf16(hi1[2], hi1[3]);
                *(u32x4*)(p + 32) = w;
                asm volatile("" ::: "memory");
            }
    }
};
template <class Epi, class Sched, bool ALIGN_EPI = false, bool SP2 = false>
__device__ __forceinline__ void gemm_phase(PG8_LAS unsigned char* lds, const Gemm g, const Sched& S, const Epi& E) {
    const int tid = opaque_tid(), wid = __builtin_amdgcn_readfirstlane(tid >> 6), lane = tid & 63, wr = wid >> 2, wc = wid & 3, fr = lane & 15, fq = lane >> 4;
    const int K = g.K, nt = K / BK;
    unsigned voffA[2], voffB[2];
#pragma unroll
    for (int i = 0; i < 2; ++i) { int R, C; stage_rc(tid * 16 + i * 8192, R, C); const int Rb = Epi::PERM ? ((R & ~31) + perm32(R & 31)) : R;
        voffA[i] = (unsigned)(R * K + C) * 2u; voffB[i] = (unsigned)(Rb * K + C) * 2u; }
    const size_t kstep = (size_t)(BK * 2);
    const size_t hstep = (size_t)HALF * K * 2;
    const size_t tstep = 2 * hstep;
    const unsigned ldsw = (unsigned)wid * 1024u;
    const int aoff = lds_byte(wr * 64 + fr, fq * 8), boff = lds_byte(wc * 32 + fr, fq * 8);
#define PG8_SA(b, h) (((b) * 2 + (h)) * HTB)
#define PG8_SB(b, h) ((4 + (b) * 2 + (h)) * HTB)
#define PG8_STAGE(bufoff, gbase, voff) do { _Pragma("unroll") for (int _i = 0; _i < 2; ++_i) \
        __builtin_amdgcn_global_load_lds((const unsigned*)((const char*)(gbase) + (voff)[_i]), (PG8_LAS unsigned*)(lds + (bufoff) + ldsw + _i * 8192), 16, 0, 0); } while (0)
#define PG8_LDA(dst, b, h) do { _Pragma("unroll") for (int m = 0; m < 4; ++m) _Pragma("unroll") for (int k = 0; k < 2; ++k) dst[m][k] = *(const PG8_LAS bf16x8*)(lds + PG8_SA(b, h) + aoff + m * 2048 + k * 1024); } while (0)
#define PG8_LDB(dst, b, h) do { _Pragma("unroll") for (int n = 0; n < 2; ++n) _Pragma("unroll") for (int k = 0; k < 2; ++k) dst[n][k] = *(const PG8_LAS bf16x8*)(lds + PG8_SB(b, h) + boff + n * 2048 + k * 1024); } while (0)
#define PG8_MMA(ai, bj, At, Bt) do { __builtin_amdgcn_s_setprio(1); _Pragma("unroll") for (int m = 0; m < 4; ++m) _Pragma("unroll") for (int n = 0; n < 2; ++n) _Pragma("unroll") for (int k = 0; k < 2; ++k) \
        acc[ai][bj][m][n] = __builtin_amdgcn_mfma_f32_16x16x32_bf16(Bt[n][k], At[m][k], acc[ai][bj][m][n], 0, 0, 0); __builtin_amdgcn_s_setprio(0); } while (0)
#define PG8_WAIT_V(n) asm volatile("s_waitcnt vmcnt(" #n ")" ::: "memory")
#define PG8_WAIT_L(n) asm volatile("s_waitcnt lgkmcnt(" #n ")" ::: "memory")
#define PG8_BAR __builtin_amdgcn_s_barrier()
#define PG8_SCHED __builtin_amdgcn_sched_barrier(0)
    Unit cur, nxt; int ui = 0;
    if (!S.next(0, cur)) return;
    f32x4 acc[2][2][4][2];
#pragma unroll
    for (int a = 0; a < 2; ++a)
#pragma unroll
        for (int b = 0; b < 2; ++b)
#pragma unroll
            for (int m = 0; m < 4; ++m)
#pragma unroll
                for (int n = 0; n < 2; ++n) acc[a][b][m][n] = (f32x4){0.f, 0.f, 0.f, 0.f};
    bf16x8 At[4][2], B0[2][2], B1[2][2];
    const char* cA = (const char*)g.A + (size_t)cur.pm * tstep; const char* cB = (const char*)g.Bt + (size_t)cur.pn * tstep;
    S.a_ready(cur);
    if constexpr (SP2) {
        PG8_STAGE(PG8_SB(0, 0), cB, voffB); PG8_STAGE(PG8_SB(0, 1), cB + hstep, voffB); PG8_STAGE(PG8_SA(0, 0), cA, voffA); PG8_STAGE(PG8_SA(0, 1), cA + hstep, voffA);
        if (wr == 1) PG8_BAR;
        PG8_WAIT_V(2); PG8_BAR;
        PG8_STAGE(PG8_SB(1, 0), cB + kstep, voffB); PG8_STAGE(PG8_SA(1, 0), cA + kstep, voffA); PG8_STAGE(PG8_SB(1, 1), cB + hstep + kstep, voffB);
        PG8_WAIT_V(6); PG8_BAR;
    } else {
        PG8_STAGE(PG8_SB(0, 0), cB, voffB); PG8_STAGE(PG8_SA(0, 0), cA, voffA); PG8_STAGE(PG8_SB(0, 1), cB + hstep, voffB); PG8_STAGE(PG8_SA(0, 1), cA + hstep, voffA);
        if (wr == 1) PG8_BAR;
        PG8_WAIT_V(4); PG8_BAR;
        PG8_STAGE(PG8_SB(1, 0), cB + kstep, voffB); PG8_STAGE(PG8_SA(1, 0), cA + kstep, voffA); PG8_STAGE(PG8_SB(1, 1), cB + hstep + kstep, voffB);
        PG8_WAIT_V(6); PG8_BAR;
    }
    for (;;) {
        const bool has_next = S.next(ui + 1, nxt);
        const char* nA = has_next ? (const char*)g.A + (size_t)nxt.pm * tstep : cA; const char* nB = has_next ? (const char*)g.Bt + (size_t)nxt.pn * tstep : cB;
        for (int t = 0; t < nt; t += 2) {
            const bool last = (t == nt - 2);
            const char* a1 = cA + (size_t)(t + 1) * kstep;
            const char* a2 = last ? nA : cA + (size_t)(t + 2) * kstep; const char* b2 = last ? nB : cB + (size_t)(t + 2) * kstep;
            const char* a3 = a2 + kstep; const char* b3 = b2 + kstep;
            if (last && has_next) S.a_ready(nxt);
            if constexpr (SP2) {
            PG8_LDB(B0, 0, 0); PG8_LDB(B1, 0, 1); PG8_SCHED; PG8_LDA(At, 0, 0); PG8_STAGE(PG8_SA(1, 1), a1 + hstep, voffA);
            PG8_WAIT_V(8); PG8_WAIT_L(0); PG8_BAR; PG8_MMA(0, 0, At, B0); PG8_MMA(0, 1, At, B1); PG8_BAR; PG8_SCHED;
            PG8_LDA(At, 0, 1); PG8_STAGE(PG8_SB(0, 0), b2, voffB); PG8_STAGE(PG8_SB(0, 1), b2 + hstep, voffB); PG8_STAGE(PG8_SA(0, 0), a2, voffA);
            PG8_WAIT_V(8); PG8_WAIT_L(0); PG8_BAR; PG8_MMA(1, 0, At, B0); PG8_MMA(1, 1, At, B1); PG8_BAR; PG8_SCHED;
            PG8_LDB(B0, 1, 0); PG8_LDB(B1, 1, 1); PG8_SCHED; PG8_LDA(At, 1, 0); PG8_STAGE(PG8_SA(0, 1), a2 + hstep, voffA);
            PG8_WAIT_V(8); PG8_WAIT_L(0); PG8_BAR; PG8_MMA(0, 0, At, B0); PG8_MMA(0, 1, At, B1); PG8_BAR; PG8_SCHED;
            PG8_LDA(At, 1, 1); PG8_STAGE(PG8_SB(1, 0), b3, voffB); PG8_STAGE(PG8_SB(1, 1), b3 + hstep, voffB); PG8_STAGE(PG8_SA(1, 0), a3, voffA);
            PG8_WAIT_V(8); PG8_WAIT_L(0); PG8_BAR; PG8_MMA(1, 0, At, B0); PG8_MMA(1, 1, At, B1); PG8_BAR; PG8_SCHED;
            } else {
            PG8_LDB(B0, 0, 0); PG8_SCHED; PG8_LDA(At, 0, 0); PG8_STAGE(PG8_SA(1, 1), a1 + hstep, voffA);
            PG8_WAIT_L(8); PG8_BAR; PG8_WAIT_L(0); PG8_MMA(0, 0, At, B0); PG8_BAR; PG8_SCHED;
            PG8_LDB(B1, 0, 1); PG8_STAGE(PG8_SB(0, 0), b2, voffB);
            PG8_BAR; PG8_WAIT_L(0); PG8_MMA(0, 1, At, B1); PG8_BAR;
            PG8_LDA(At, 0, 1); PG8_STAGE(PG8_SA(0, 0), a2, voffA);
            PG8_BAR; PG8_WAIT_L(0); PG8_MMA(1, 0, At, B0); PG8_BAR; PG8_SCHED;
            PG8_STAGE(PG8_SB(0, 1), b2 + hstep, voffB);
            PG8_WAIT_V(6); PG8_BAR; PG8_MMA(1, 1, At, B1); PG8_BAR;
            PG8_LDB(B0, 1, 0); PG8_SCHED; PG8_LDA(At, 1, 0); PG8_STAGE(PG8_SA(0, 1), a2 + hstep, voffA);
            PG8_WAIT_L(8); PG8_BAR; PG8_WAIT_L(0); PG8_MMA(0, 0, At, B0); PG8_BAR; PG8_SCHED;
            PG8_LDB(B1, 1, 1); PG8_STAGE(PG8_SB(1, 0), b3, voffB);
            PG8_BAR; PG8_WAIT_L(0); PG8_MMA(0, 1, At, B1); PG8_BAR;
            PG8_LDA(At, 1, 1); PG8_STAGE(PG8_SA(1, 0), a3, voffA);
            PG8_BAR; PG8_WAIT_L(0); PG8_MMA(1, 0, At, B0); PG8_BAR; PG8_SCHED;
            PG8_STAGE(PG8_SB(1, 1), b3 + hstep, voffB);
            PG8_WAIT_V(6); PG8_BAR; PG8_MMA(1, 1, At, B1); PG8_BAR;
            }
        }
        if constexpr (ALIGN_EPI) { if (wr == 0) PG8_BAR; }
        if constexpr (!Epi::AFTER_DRAIN) { E(acc, cur, wr, wc, fr, fq); S.done(cur); }
        if (!has_next) break;
#pragma unroll
        for (int a = 0; a < 2; ++a)
#pragma unroll
            for (int b = 0; b < 2; ++b)
#pragma unroll
                for (int m = 0; m < 4; ++m)
#pragma unroll
                    for (int n = 0; n < 2; ++n) acc[a][b][m][n] = (f32x4){0.f, 0.f, 0.f, 0.f};
        cur = nxt; cA = nA; cB = nB; ++ui;
        if constexpr (ALIGN_EPI) { if (wr == 1) PG8_BAR; }
    }
    PG8_WAIT_V(0);
    if constexpr (!ALIGN_EPI) { if (wr == 0) PG8_BAR; }
    PG8_BAR;
    if constexpr (Epi::AFTER_DRAIN) { E.fused(acc, cur, wr, wc, fr, fq, lds, wid, lane); S.done(cur); }
#undef PG8_SA
#undef PG8_SB
#undef PG8_STAGE
#undef PG8_LDA
#undef PG8_LDB
#undef PG8_MMA
#undef PG8_WAIT_V
#undef PG8_WAIT_L
#undef PG8_BAR
#undef PG8_SCHED
}
}
#include <hip/hip_bf16.h>
#include <cmath>
namespace attn_body {
using bf16=__hip_bfloat16;
using bf16x8=__attribute__((ext_vector_type(8)))short;
using s16x4=__attribute__((ext_vector_type(4)))short;
using f32x16=__attribute__((ext_vector_type(16)))float;
using u32x4=__attribute__((ext_vector_type(4)))unsigned;
constexpr int D=64,QP=512,KP=128;
constexpr int NW=8,QBLK=32,QB=QBLK*NW,KVBLK=64;
__device__ __forceinline__ int crow(int r,int hi){return (r&3)+8*(r>>2)+4*hi;}
#define SBAR() __builtin_amdgcn_sched_barrier(0)

constexpr int NSLOT=3, SLOTB=8192;
constexpr int LDS_K=0, LDS_V=NSLOT*SLOTB, LDS_WS=2*NSLOT*SLOTB, LDS_OST=LDS_WS+NW*64*4, LDS_BYTES=LDS_OST+NW*4096;
constexpr float C2=0.125f*1.4426950408889634f;
__device__ __forceinline__ void glds16(const void*gsrc,unsigned lds_dst){unsigned keep;
  asm volatile("s_mov_b32 %0, m0\n\ts_mov_b32 m0, %2\n\ts_nop 0\n\tglobal_load_lds_dwordx4 %1, off\n\ts_mov_b32 m0, %0":"=&s"(keep):"v"(gsrc),"s"(lds_dst):"memory");}
__device__ __forceinline__ float max3f(float a,float b,float c){float r;asm("v_max3_f32 %0, %1, %2, %3":"=v"(r):"v"(a),"v"(b),"v"(c));return r;}
__device__ __forceinline__ float max2f(float a,float b){float r;asm("v_max_f32_e32 %0, %1, %2":"=v"(r):"v"(a),"v"(b));return r;}
__device__ __forceinline__ float fadd_s(float a,float b){float r;asm("v_add_f32_e32 %0, %1, %2":"=v"(r):"v"(a),"v"(b));return r;}
__device__ __forceinline__ float fsub_s(float a,float b){float r;asm("v_sub_f32_e32 %0, %1, %2":"=v"(r):"v"(a),"v"(b));return r;}
typedef float f32x2_t __attribute__((ext_vector_type(2))); typedef __bf16 bf16x2_t __attribute__((ext_vector_type(2)));
__device__ __forceinline__ unsigned cvtpk_s(float lo,float hi){f32x2_t v={lo,hi};bf16x2_t b=__builtin_convertvector(v,bf16x2_t);return __builtin_bit_cast(unsigned,b);}
#define WAIT_BAR(N) asm volatile("s_waitcnt vmcnt(" #N ") lgkmcnt(0)\n\ts_barrier":::"memory")

__device__ __forceinline__ void qkt(f32x16&p0,f32x16&p1,const char*Kslot,const bf16x8*qr,const f32x16&negm,int r32,int hi){
  const char*kb=Kslot+hi*1024+r32*16;
  #pragma unroll
  for(int d0=0;d0<4;++d0){
    const bf16x8 b0=*reinterpret_cast<const bf16x8*>(kb+d0*2048);
    const bf16x8 b1=*reinterpret_cast<const bf16x8*>(kb+d0*2048+512);
    if(d0==0){p0=__builtin_amdgcn_mfma_f32_32x32x16_bf16(b0,qr[0],negm,0,0,0);p1=__builtin_amdgcn_mfma_f32_32x32x16_bf16(b1,qr[0],negm,0,0,0);}
    else{p0=__builtin_amdgcn_mfma_f32_32x32x16_bf16(b0,qr[d0],p0,0,0,0);p1=__builtin_amdgcn_mfma_f32_32x32x16_bf16(b1,qr[d0],p1,0,0,0);}}
}
typedef __attribute__((address_space(3))) const char* lds_cptr;
typedef short v4i16_t __attribute__((ext_vector_type(4)));
__device__ __forceinline__ void kload8(bf16x8*kf,lds_cptr kp){
  kf[0]=*(const __attribute__((address_space(3))) bf16x8*)(kp);      kf[1]=*(const __attribute__((address_space(3))) bf16x8*)(kp+512);
  kf[2]=*(const __attribute__((address_space(3))) bf16x8*)(kp+2048); kf[3]=*(const __attribute__((address_space(3))) bf16x8*)(kp+2560);
  kf[4]=*(const __attribute__((address_space(3))) bf16x8*)(kp+4096); kf[5]=*(const __attribute__((address_space(3))) bf16x8*)(kp+4608);
  kf[6]=*(const __attribute__((address_space(3))) bf16x8*)(kp+6144); kf[7]=*(const __attribute__((address_space(3))) bf16x8*)(kp+6656);
}
__device__ __forceinline__ void kload2(bf16x8*kf,lds_cptr kp,int j){ kf[2*j]=*(const __attribute__((address_space(3))) bf16x8*)(kp+j*2048); kf[2*j+1]=*(const __attribute__((address_space(3))) bf16x8*)(kp+j*2048+512); }
__device__ __forceinline__ s16x4 vtr(lds_cptr p){ return __builtin_bit_cast(s16x4,__builtin_amdgcn_ds_read_tr16_b64_v4i16((__attribute__((address_space(3))) v4i16_t*)p)); }
__device__ __forceinline__ float rowmax(const f32x16&p0,const f32x16&p1){
  float a=max3f(p0[0],p0[1],p1[0]),b=max3f(p0[2],p0[3],p1[1]);a=max3f(a,p1[2],p1[3]);
  #pragma unroll
  for(int r=4;r<16;r+=4){a=max3f(a,p0[r],p0[r+1]);b=max3f(b,p0[r+2],p0[r+3]);a=max3f(a,p1[r],p1[r+1]);b=max3f(b,p1[r+2],p1[r+3]);}
  const float m=max2f(a,b);
  auto rr=__builtin_amdgcn_permlane32_swap(__float_as_uint(m),__float_as_uint(m),false,false);
  return max2f(__uint_as_float(rr[0]),__uint_as_float(rr[1]));
}
__device__ __forceinline__ void pv(f32x16*o,int vb,bf16x8 pa0,bf16x8 pa1,bf16x8 pa2,bf16x8 pa3){
  #pragma unroll
  for(int d0=0;d0<2;++d0){s16x4 lo[4],hi[4];
    #pragma unroll
    for(int ks=0;ks<4;++ks){
      asm volatile("ds_read_b64_tr_b16 %0,%1 offset:%c2":"=&v"(lo[ks]):"v"(vb),"i"(d0*4096+ks*1024):"memory");
      asm volatile("ds_read_b64_tr_b16 %0,%1 offset:%c2":"=&v"(hi[ks]):"v"(vb),"i"(d0*4096+ks*1024+512):"memory");}
    asm volatile("s_waitcnt lgkmcnt(0)":::"memory");SBAR();
    #define PK(k) (bf16x8){lo[k][0],lo[k][1],lo[k][2],lo[k][3],hi[k][0],hi[k][1],hi[k][2],hi[k][3]}
    o[d0]=__builtin_amdgcn_mfma_f32_32x32x16_bf16(pa0,PK(0),o[d0],0,0,0);
    o[d0]=__builtin_amdgcn_mfma_f32_32x32x16_bf16(pa1,PK(1),o[d0],0,0,0);
    o[d0]=__builtin_amdgcn_mfma_f32_32x32x16_bf16(pa2,PK(2),o[d0],0,0,0);
    o[d0]=__builtin_amdgcn_mfma_f32_32x32x16_bf16(pa3,PK(3),o[d0],0,0,0);
    #undef PK
  }
}

#ifndef ATTN_STORE16
#define ATTN_STORE16(p,v) (*(u32x4*)(p)=(v))
#endif
template<int THRL> __device__ __forceinline__ void attn_unit(long rowbase,int T,int h,int qb,const bf16*Q,const bf16*__restrict__ K,const bf16*__restrict__ V,bf16*O,char*shm){
  const int tid=pg8::opaque_tid(),lane=tid&63,r32=lane&31,hi=lane>>5; const int wid=__builtin_amdgcn_readfirstlane(tid>>6);
  const int q0=qb*QB;
  const bf16*Qw=Q+(rowbase+q0+wid*QBLK)*QP+h*D;
  const bf16*Kh=K+rowbase*KP+(h>>2)*D,*Vh=V+rowbase*KP+(h>>2)*D;
  const unsigned lds0=(unsigned)(uintptr_t)shm;
  float*wsf=(float*)(shm+LDS_WS)+wid*64;
  const bf16*ksrc=Kh+(long)lane*KP+wid*8;
  const bf16*vsrc=Vh+(long)(16*(wid&3)+(lane>>2))*KP+(wid>>2)*32+(lane&3)*8;
  const unsigned kdst=lds0+LDS_K+wid*1024, vdst=lds0+LDS_V+wid*1024;
  #define DMA_K(t,slot) glds16(ksrc+(long)(t)*KVBLK*KP,(unsigned)__builtin_amdgcn_readfirstlane(kdst+(slot)))
  #define DMA_V(t,slot) glds16(vsrc+(long)(t)*KVBLK*KP,(unsigned)__builtin_amdgcn_readfirstlane(vdst+(slot)))
  const int vb0=(int)(lds0+LDS_V)+((lane>>4)&1)*32+(lane&3)*8+(4*hi+((lane&15)>>2))*64;
  const char*Kbase=shm+LDS_K; bf16x8 kf[8];
  const lds_cptr shm3=(lds_cptr)shm; const lds_cptr kp0=shm3+LDS_K+hi*1024+r32*16; const lds_cptr vp0=shm3+LDS_V+((lane>>4)&1)*32+(lane&3)*8+(4*hi+((lane&15)>>2))*64;
  const int NT=T/KVBLK;
  DMA_K(0,0);DMA_V(0,0);DMA_K(1,SLOTB);
  bf16x8 qr[4];
  #pragma unroll
  for(int d0=0;d0<4;++d0)qr[d0]=*reinterpret_cast<const bf16x8*>(&Qw[(long)r32*QP+d0*16+hi*8]);
  float mhat=0.f,l_reg=0.f;f32x16 o[2];o[0]=f32x16{};o[1]=f32x16{};f32x16 negm=f32x16{};asm volatile("":"+v"(negm));
  #define CMASK(P0,P1,t) do{}while(0)
  bool resc=false;
  #define START(P0,P1) do{ const float rm=rowmax(P0,P1); resc=false; \
    { const float dl=rm; mhat=fadd_s(mhat,dl); \
      _Pragma("unroll") for(int r=0;r<16;++r){P0[r]=fsub_s(P0[r],dl);P1[r]=fsub_s(P1[r],dl);} \
      _Pragma("unroll") for(int r=0;r<16;++r)negm[r]=-mhat; asm volatile("":"+v"(negm)); } \
    _Pragma("unroll") for(int r=0;r<16;++r)P0[r]=__builtin_amdgcn_exp2f(P0[r]); }while(0)
  #define RESC() do{ if(resc){ asm volatile("s_waitcnt lgkmcnt(0)":::"memory"); \
      _Pragma("unroll") for(int d_=0;d_<2;++d_) _Pragma("unroll") for(int r=0;r<16;++r)o[d_][r]*=wsf[crow(r,hi)]; } }while(0)
  f32x16 pA0,pA1,pB0,pB1;
  int sl_prev=0,sl_cur=0,sl_next=SLOTB;
  #define ROT() do{sl_prev=sl_cur;sl_cur=sl_next;sl_next=(sl_next==(NSLOT-1)*SLOTB)?0:sl_next+SLOTB;}while(0)
  DMA_K(2,2*SLOTB);
  WAIT_BAR(3);
  qkt(pA0,pA1,Kbase,qr,negm,r32,hi);asm volatile("s_nop 15\n\ts_nop 7":"+v"(pA0),"+v"(pA1));CMASK(pA0,pA1,0);
  START(pA0,pA1);
  _Pragma("unroll") for(int r=0;r<16;++r)pA1[r]=__builtin_amdgcn_exp2f(pA1[r]);
  WAIT_BAR(0);
  DMA_K(3,0);DMA_V(1,SLOTB);
  ROT();
  kload8(kf,kp0+sl_cur);
  WAIT_BAR(2);
  s16x4 vlo[8],vhi[8]; u32x4 pw0,pw1,pw2,pw3;
  #define PKW(P,B) cvtpk_s(P[B],P[B+1])
  #define PAF(k) __builtin_bit_cast(bf16x8,pw##k)
  #define VFR(i) (bf16x8){vlo[i][0],vlo[i][1],vlo[i][2],vlo[i][3],vhi[i][0],vhi[i][1],vhi[i][2],vhi[i][3]}
  #define PIN(x) asm volatile("":"+v"(x))
  #define MX3(a,b,c) __builtin_fmaxf(__builtin_fmaxf((a),(b)),(c))
  #define GAPA(MF,A0,A1,A2,A3,W0,W1,PW) do{ MF; sacc+=A0; sacc+=A1; sacc+=A2; sacc+=A3; PIN(sacc); W0; W1; PIN(PW); SBAR(); }while(0)
  #define EX(v) __builtin_amdgcn_exp2f(v)
  #define GAPB(MF,X,B) do{ MF; X[B]=EX(X[B]); X[B+1]=EX(X[B+1]); X[B+2]=EX(X[B+2]); X[B+3]=EX(X[B+3]); PIN(X); SBAR(); }while(0)
  #define VRD(i) do{ vlo[i]=vtr(vp_+(((i)>>2)*4096+((i)&3)*1024)); vhi[i]=vtr(vp_+(((i)>>2)*4096+((i)&3)*1024+512)); }while(0)
  #define KRD(G,j) do{ if(G){ kload2(kf,kp0+sl_next,j); SBAR(); } }while(0)
  #define STEP(C0,C1,P0,P1,t,GK,GV,GL) do{ SBAR(); \
    const lds_cptr vp_=vp0+sl_prev; \
    VRD(0); SBAR(); float sacc=(P0[0]+P0[1]); \
    GAPA(C0=__builtin_amdgcn_mfma_f32_32x32x16_bf16(kf[0],qr[0],negm,0,0,0), P0[2],P0[3],P0[4],P0[5],     pw0[0]=PKW(P0,0), pw0[1]=PKW(P0,2), pw0); \
    VRD(4); SBAR(); GAPA(C1=__builtin_amdgcn_mfma_f32_32x32x16_bf16(kf[1],qr[0],negm,0,0,0), P0[6],P0[7],P0[8],P0[9],     pw0[2]=PKW(P0,4), pw0[3]=PKW(P0,6), pw0); \
    VRD(1); SBAR(); GAPA(C0=__builtin_amdgcn_mfma_f32_32x32x16_bf16(kf[2],qr[1],C0,0,0,0),   P0[10],P0[11],P0[12],P0[13], pw1[0]=PKW(P0,8), pw1[1]=PKW(P0,10), pw1); \
    VRD(5); SBAR(); GAPA(C1=__builtin_amdgcn_mfma_f32_32x32x16_bf16(kf[3],qr[1],C1,0,0,0),   P0[14],P0[15],P1[0],P1[1],   pw1[2]=PKW(P0,12),pw1[3]=PKW(P0,14), pw1); \
    VRD(2); SBAR(); GAPA(C0=__builtin_amdgcn_mfma_f32_32x32x16_bf16(kf[4],qr[2],C0,0,0,0),   P1[2],P1[3],P1[4],P1[5],     pw2[0]=PKW(P1,0), pw2[1]=PKW(P1,2), pw2); \
    VRD(6); SBAR(); GAPA(C1=__builtin_amdgcn_mfma_f32_32x32x16_bf16(kf[5],qr[2],C1,0,0,0),   P1[6],P1[7],P1[8],P1[9],     pw2[2]=PKW(P1,4), pw2[3]=PKW(P1,6), pw2); \
    VRD(3); SBAR(); GAPA(C0=__builtin_amdgcn_mfma_f32_32x32x16_bf16(kf[6],qr[3],C0,0,0,0),   P1[10],P1[11],P1[12],P1[13], pw3[0]=PKW(P1,8), pw3[1]=PKW(P1,10), pw3); \
    VRD(7); SBAR(); GAPA(C1=__builtin_amdgcn_mfma_f32_32x32x16_bf16(kf[7],qr[3],C1,0,0,0),   P1[14],P1[15],0.f,0.f,       pw3[2]=PKW(P1,12),pw3[3]=PKW(P1,14), pw3); \
    l_reg+=sacc; \
    if(GK){DMA_K((t)+3,sl_cur);} if(GV){DMA_V((t)+1,sl_next);} \
    CMASK(C0,C1,t); \
    { float a=MX3(C0[0],C0[1],C1[0]),b=MX3(C0[2],C0[3],C1[1]); a=MX3(a,C1[2],C1[3]); \
      _Pragma("unroll") for(int r=4;r<16;r+=4){a=MX3(a,C0[r],C0[r+1]);b=MX3(b,C0[r+2],C0[r+3]);a=MX3(a,C1[r],C1[r+1]);b=MX3(b,C1[r+2],C1[r+3]);} \
      float rm=__builtin_fmaxf(a,b); { auto rr=__builtin_amdgcn_permlane32_swap(__float_as_uint(rm),__float_as_uint(rm),false,false); rm=__builtin_fmaxf(__uint_as_float(rr[0]),__uint_as_float(rr[1])); } \
      resc=false; \
      if(__builtin_expect(__any(rm>(float)THRL),0)){ const float dl=__builtin_fmaxf(rm,0.f); mhat+=dl; \
        _Pragma("unroll") for(int r=0;r<16;++r){C0[r]-=dl;C1[r]-=dl;} \
        _Pragma("unroll") for(int r=0;r<16;++r)negm[r]=-mhat; asm volatile("":"+v"(negm)); \
        const float f=__builtin_amdgcn_exp2f(-dl); l_reg*=f; if(hi==0)wsf[r32]=f; resc=true; } } \
    SBAR(); \
    GAPB(o[0]=__builtin_amdgcn_mfma_f32_32x32x16_bf16(PAF(0),VFR(0),o[0],0,0,0), C0,0); \
    GAPB(o[1]=__builtin_amdgcn_mfma_f32_32x32x16_bf16(PAF(0),VFR(4),o[1],0,0,0), C0,4); \
    KRD(GL,0); GAPB(o[0]=__builtin_amdgcn_mfma_f32_32x32x16_bf16(PAF(1),VFR(1),o[0],0,0,0), C0,8); \
    KRD(GL,1); GAPB(o[1]=__builtin_amdgcn_mfma_f32_32x32x16_bf16(PAF(1),VFR(5),o[1],0,0,0), C0,12); \
    KRD(GL,2); GAPB(o[0]=__builtin_amdgcn_mfma_f32_32x32x16_bf16(PAF(2),VFR(2),o[0],0,0,0), C1,0); \
    KRD(GL,3); GAPB(o[1]=__builtin_amdgcn_mfma_f32_32x32x16_bf16(PAF(2),VFR(6),o[1],0,0,0), C1,4); \
    GAPB(o[0]=__builtin_amdgcn_mfma_f32_32x32x16_bf16(PAF(3),VFR(3),o[0],0,0,0), C1,8); \
    GAPB(o[1]=__builtin_amdgcn_mfma_f32_32x32x16_bf16(PAF(3),VFR(7),o[1],0,0,0), C1,12); \
    }while(0)
  int t=1;
  #undef CMASK
  #define CMASK(P0,P1,t) do{}while(0)
  for(;t+5<NT;t+=2){
    STEP(pB0,pB1,pA0,pA1,t,true,true,true);     WAIT_BAR(2); RESC(); ROT();
    STEP(pA0,pA1,pB0,pB1,t+1,true,true,true);   WAIT_BAR(2); RESC(); ROT();
  }
  #undef CMASK
  #define CMASK(P0,P1,t) do{}while(0)
  #define ENDW(tt) do{ if((tt)+3<NT){WAIT_BAR(2);} else if((tt)+2<NT){WAIT_BAR(1);} else {WAIT_BAR(0);} }while(0)
  for(;t+1<NT;t+=2){
    STEP(pB0,pB1,pA0,pA1,t,(t+3<NT),(t+1<NT),(t+1<NT));       ENDW(t);   RESC(); ROT();
    STEP(pA0,pA1,pB0,pB1,t+1,(t+4<NT),(t+2<NT),(t+2<NT));     ENDW(t+1); RESC(); ROT();
  }
  STEP(pB0,pB1,pA0,pA1,NT-1,false,false,false); RESC();
  { float sacc=pB0[0]+pB0[1]; _Pragma("unroll") for(int r=2;r<16;++r)sacc+=pB0[r]; _Pragma("unroll") for(int r=0;r<16;++r)sacc+=pB1[r]; l_reg+=sacc;
    pw0=(u32x4){PKW(pB0,0),PKW(pB0,2),PKW(pB0,4),PKW(pB0,6)};pw1=(u32x4){PKW(pB0,8),PKW(pB0,10),PKW(pB0,12),PKW(pB0,14)};pw2=(u32x4){PKW(pB1,0),PKW(pB1,2),PKW(pB1,4),PKW(pB1,6)};pw3=(u32x4){PKW(pB1,8),PKW(pB1,10),PKW(pB1,12),PKW(pB1,14)};
    SBAR(); pv(o,vb0+sl_cur,PAF(0),PAF(1),PAF(2),PAF(3)); }
  #undef PKW
  #undef PAF
  #undef VFR
  #undef PIN
  #undef MX3
  #undef GAPA
  #undef GAPB
  #undef EX
  #undef VRD
  #undef KRD
  #undef STEP
  #undef ENDW
  {auto rr=__builtin_amdgcn_permlane32_swap(__float_as_uint(l_reg),__float_as_uint(l_reg),false,false);l_reg=__uint_as_float(rr[0])+__uint_as_float(rr[1]);}
  if(hi==0)wsf[32+r32]=l_reg;asm volatile("s_waitcnt lgkmcnt(0)":::"memory");
  float rli[16];
  #pragma unroll
  for(int r=0;r<16;++r)rli[r]=__builtin_amdgcn_rcpf(wsf[32+crow(r,hi)]);
  bf16*Ow=O+(rowbase+q0+wid*QBLK)*QP+h*D;
  { bf16*stg=(bf16*)(shm+LDS_OST)+wid*2048;
    #pragma unroll
    for(int r=0;r<16;++r){const int orow=crow(r,hi);
      #pragma unroll
      for(int d0=0;d0<2;++d0)stg[orow*64+d0*32+r32]=__float2bfloat16(o[d0][r]*rli[r]);}
    asm volatile("s_waitcnt lgkmcnt(0)":::"memory");
    #pragma unroll
    for(int i=0;i<4;++i){const int row=i*8+(lane>>3),ch=lane&7; const u32x4 v=*(const u32x4*)(stg+row*64+ch*8); ATTN_STORE16(Ow+(long)row*QP+ch*8,v);} }
  asm volatile("s_waitcnt lgkmcnt(0)\n\ts_barrier":::"memory");
  #undef DMA_K
  #undef DMA_V
  #undef CMASK
  #undef START
  #undef RESC
  #undef ROT
}
constexpr int ATTN_LDS_BYTES=LDS_BYTES;
#undef SBAR
#undef WAIT_BAR
}
#define LAS __attribute__((address_space(3)))
typedef unsigned short bf16_t;
typedef unsigned v4u __attribute__((ext_vector_type(4)));
typedef unsigned v2u __attribute__((ext_vector_type(2)));
typedef float f32x4 __attribute__((ext_vector_type(4)));
typedef short bf16x8 __attribute__((ext_vector_type(8)));
typedef short s16x4 __attribute__((ext_vector_type(4)));

constexpr int NWAVES = 8, NTHREADS = 512;
constexpr int M_TOK = 49152, DMODEL = 1024, DFF = 2816, NPROJ = 2304, DEPTH = 4;
constexpr int PROMPT_ROWS = 16384;
constexpr int NCHUNK = M_TOK / 128;
constexpr int NRET_ITEMS = NCHUNK * 4;
constexpr float NORM_EPS = 1e-6f;
constexpr float ATT_C2 = 0.125f * 1.4426950408889634f;

constexpr size_t OW13A = 0, OW2A = OW13A + (size_t)5632 * 1024, OWIN = OW2A + (size_t)1024 * 2816, OWG = OWIN + (size_t)2304 * 1024, OWBA = OWG + (size_t)2048 * 1024,
                 OWBR = OWBA + (size_t)1024 * 512, OWO = OWBR + (size_t)1024 * 512, OW13B = OWO + (size_t)1024 * 1024, OW2B = OW13B + (size_t)5632 * 1024, OWEND = OW2B + (size_t)1024 * 2816;
constexpr size_t MiB = 1u << 20;
constexpr size_t WS_ROPE = 0;
constexpr size_t WS_BAR = 65536;
constexpr int LDS_MISC = 131072;
constexpr size_t WS_WB = 1 * MiB;
constexpr size_t WS_XN = 48 * MiB;
constexpr size_t WS_B = 144 * MiB;
constexpr size_t WS_HB = WS_B;
constexpr size_t WS_Q = WS_B, WS_K = WS_B + 48 * MiB, WS_V = WS_B + 60 * MiB, WS_RQ = WS_B + 72 * MiB, WS_RK = WS_B + 96 * MiB, WS_RV = WS_B + 120 * MiB, WS_RG = WS_B + 168 * MiB,
                 WS_T = WS_B + 216 * MiB, WS_ST = WS_B + 312 * MiB, WS_U = WS_B;
constexpr size_t WS_SS = WS_B + 360 * MiB;
constexpr size_t WS_WB1 = WS_SS + 3 * MiB;
constexpr size_t WS_END = WS_WB1 + 46 * MiB;
static_assert(OWEND * 2 + WS_WB <= WS_XN && (size_t)M_TOK * DFF * 2 <= 264 * MiB, "ws map");
static_assert(WS_Q == WS_B + 2 * pg8::EpiInProj::EQ && WS_K == WS_B + 2 * pg8::EpiInProj::EK && WS_V == WS_B + 2 * pg8::EpiInProj::EV && WS_RQ == WS_B + 2 * pg8::EpiInProj::ERQ && WS_RK == WS_B + 2 * pg8::EpiInProj::ERK && WS_RV == WS_B + 2 * pg8::EpiInProj::ERV && WS_RG == WS_B + 2 * pg8::EpiInProj::ERG, "in-proj epilogue offsets");

constexpr int LDS_BYTES = 147456;
constexpr int NPHASE = 1 + 11 * DEPTH + 1;

__device__ __forceinline__ unsigned f2bf(float f) { unsigned u = __builtin_bit_cast(unsigned, f); return (u + 0x7fffu + ((u >> 16) & 1u)) >> 16; }
__device__ __forceinline__ unsigned pk2(float lo, float hi) { return pg8::cvt_pk_bf16(lo, hi); }
__device__ __forceinline__ float bfl(unsigned w) { return __uint_as_float(w << 16); }
__device__ __forceinline__ float bfh(unsigned w) { return __uint_as_float(w & 0xffff0000u); }
__device__ __forceinline__ float wave_sum(float v) {
#pragma unroll
    for (int o = 1; o < 64; o <<= 1) v += __shfl_xor(v, o);
    return v;
}
#define LDS_WAIT() asm volatile("s_waitcnt lgkmcnt(0)" ::: "memory")

#define RLX_AGENT __ATOMIC_RELAXED, __HIP_MEMORY_SCOPE_AGENT
#define XB_TMO      128
#define XB_XCNT(j)  (256  + 64 * (j))
#define XB_XSUB(j)  (1280 + 64 * (j))
#define XB_XGEN(j)  (2304 + 64 * (j))
#define XB_TOP      3328
#define XB_TOPGEN   3392
#define XCD_BAR_WORDS 3456
#define XB_SPIN_CAP (1u << 18)

__device__ __forceinline__ unsigned xb_ld(unsigned* p)              { return __hip_atomic_load(p, __ATOMIC_RELAXED, __HIP_MEMORY_SCOPE_AGENT); }
__device__ __forceinline__ unsigned xb_add(unsigned* p, unsigned v) { return __hip_atomic_fetch_add(p, v, __ATOMIC_RELAXED, __HIP_MEMORY_SCOPE_AGENT); }
__device__ __forceinline__ unsigned xb_xcc_id() { return (unsigned)__builtin_amdgcn_s_getreg((3 << 11) | 20) & 0xFu; }
#define XB_SPIN(cond, bar) do { unsigned _sp = 0; while (cond) { __builtin_amdgcn_s_sleep(1); \
    if ((++_sp & 255u) == 0u) { if (xb_ld(&(bar)[XB_TMO])) break; if (_sp > XB_SPIN_CAP) { atomicAdd(&(bar)[XB_TMO], 1u); break; } } } } while (0)

struct XcdBarrier {
    unsigned* bar; unsigned x;
    volatile LAS unsigned* st;
};

__device__ __forceinline__ XcdBarrier xcd_barrier_post(unsigned* bar, volatile LAS unsigned* st) {
    XcdBarrier b; b.bar = bar; b.x = xb_xcc_id(); b.st = st;
    if (threadIdx.x == 0) (void)xb_add(&bar[XB_XCNT(b.x)], 1u);
    return b;
}
__device__ __forceinline__ void xcd_barrier_complete(unsigned* bar, unsigned x, unsigned& nloc, unsigned& nx) {
    const unsigned G = gridDim.x * gridDim.y * gridDim.z;
    unsigned sum, cnt, mine, sp = 0u;
    for (;;) {
        sum = 0u; cnt = 0u; mine = 0u;
#pragma unroll
        for (unsigned j = 0; j < 16; ++j) { const unsigned c = xb_ld(&bar[XB_XCNT(j)]); sum += c; cnt += (c > 0u) ? 1u : 0u; mine = (j == x) ? c : mine; }
        if (sum == G) break;
        __builtin_amdgcn_s_sleep(1);
        if ((++sp & 255u) == 0u) { if (xb_ld(&bar[XB_TMO])) break; if (sp > XB_SPIN_CAP) { atomicAdd(&bar[XB_TMO], 1u); break; } }
    }
    nloc = mine > 0u ? mine : 1u; nx = cnt > 0u ? cnt : 1u;
}

__device__ __forceinline__ void xcd_barrier(const XcdBarrier& b) {
    asm volatile("s_waitcnt vmcnt(0)" ::: "memory");
    __syncthreads();
    if (threadIdx.x == 0) {
        unsigned* bar = b.bar;
        __builtin_amdgcn_s_waitcnt(0);
        unsigned nloc = b.st[0], nx = b.st[1];
        if (nloc == 0u) { xcd_barrier_complete(bar, b.x, nloc, nx); b.st[0] = nloc; b.st[1] = nx; }
        const unsigned old = xb_add(&bar[XB_XSUB(b.x)], 1u);
        const unsigned gen = old / nloc;
        if (old + 1u == (gen + 1u) * nloc) {
            __builtin_amdgcn_fence(__ATOMIC_RELEASE, "agent");
            asm volatile("s_waitcnt vmcnt(0)" ::: "memory");
            const unsigned og = xb_add(&bar[XB_TOP], 1u);
            const unsigned tg = og / nx;
            if (og + 1u == (tg + 1u) * nx) xb_add(&bar[XB_TOPGEN], 1u);
            else XB_SPIN(xb_ld(&bar[XB_TOPGEN]) == tg, bar);
            __builtin_amdgcn_fence(__ATOMIC_ACQUIRE, "agent");
            xb_add(&bar[XB_XGEN(b.x)], 1u);
            asm volatile("s_waitcnt vmcnt(0)" ::: "memory");
        } else {
            XB_SPIN(xb_ld(&bar[XB_XGEN(b.x)]) == gen, bar);
            __builtin_amdgcn_fence(__ATOMIC_ACQUIRE, "agent");
            asm volatile("s_waitcnt vmcnt(0)" ::: "memory");
        }
    }
    __syncthreads();
}

__device__ __forceinline__ void transpose_item(const float* W, const float* gk, int K, int N, bf16_t* WT, int map, LAS float* scr, int item, int lane) {
    const int nblk = N / 32, kb = item / nblk, nb = item % nblk, k0 = 64 * kb, n0 = 32 * nb;
    int drow0 = n0;
    if (map == 1) { const int half = n0 / DFF, j = n0 % DFF; drow0 = 256 * (j / 128) + 128 * half + (j % 128); }
    else if (map == 3) { const int half = n0 / 1024, j = n0 % 1024; drow0 = 256 * (j / 128) + 128 * half + (j % 128); }
    else if (map == 2) { const int pn = n0 / 256, r = n0 % 256; drow0 = 256 * pn + 128 * ((r % 64) / 32) + 32 * (r / 64); }
    { const int kr = lane >> 3, nq = (lane & 7) * 4;
        f32x4 v[8]; float gs[8];
#pragma unroll
        for (int i = 0; i < 8; ++i) { v[i] = *(const f32x4*)(W + (size_t)(k0 + 8 * i + kr) * N + n0 + nq); gs[i] = gk ? gk[k0 + 8 * i + kr] : 1.f; }
#pragma unroll
        for (int i = 0; i < 8; ++i) { LAS float* d = scr + (8 * i + kr) * 33 + nq; d[0] = v[i][0] * gs[i]; d[1] = v[i][1] * gs[i]; d[2] = v[i][2] * gs[i]; d[3] = v[i][3] * gs[i]; } }
    LDS_WAIT(); asm volatile("" ::: "memory");
    const int c = lane & 7;
#pragma unroll
    for (int j = 0; j < 4; ++j) { const int n = (lane >> 3) + 8 * j; const LAS float* s = scr + (8 * c) * 33 + n;
        v4u o; o.x = pk2(s[0 * 33], s[1 * 33]); o.y = pk2(s[2 * 33], s[3 * 33]); o.z = pk2(s[4 * 33], s[5 * 33]); o.w = pk2(s[6 * 33], s[7 * 33]);
        *(v4u*)(WT + (size_t)(drow0 + n) * K + k0 + 8 * c) = o; }
    LDS_WAIT(); asm volatile("" ::: "memory");
}

struct Args { const float* in[21]; float* out; unsigned char* ws; int ph_lo, ph_hi; };

template <bool OUT_F32> __device__ __forceinline__ void norm_row(const float* xrow, const float* g, bf16_t* orow, float* orow_f, int lane) {
    const f32x4* xr = (const f32x4*)xrow + lane; const f32x4* gr = (const f32x4*)g + lane;
    f32x4 v[4]; float s = 0.f;
#pragma unroll
    for (int j = 0; j < 4; ++j) { v[j] = xr[64 * j]; s += (v[j].x * v[j].x + v[j].y * v[j].y) + (v[j].z * v[j].z + v[j].w * v[j].w); }
    const float rstd = 1.0f / sqrtf(wave_sum(s) * (1.0f / 1024.0f) + NORM_EPS);
#pragma unroll
    for (int j = 0; j < 4; ++j) { const f32x4 gg = gr[64 * j]; const f32x4 o = v[j] * rstd * gg;
        if (OUT_F32) ((f32x4*)orow_f)[64 * j + lane] = o;
        else { v2u w; w.x = pk2(o.x, o.y); w.y = pk2(o.z, o.w); ((v2u*)orow)[64 * j + lane] = w; } }
}

__device__ __forceinline__ void final_row(const bf16_t* hrow, const float* ssrow, const float* g, float* orow, int lane) {
    const f32x4* sp = (const f32x4*)ssrow; const f32x4 a = sp[0], b = sp[1], c = sp[2], d = sp[3];
    const float s = ((a[0] + a[1]) + (a[2] + a[3])) + ((b[0] + b[1]) + (b[2] + b[3])) + ((c[0] + c[1]) + (c[2] + c[3])) + ((d[0] + d[1]) + (d[2] + d[3]));
    const float rstd = __builtin_amdgcn_rsqf(s * (1.0f / 1024.0f) + NORM_EPS);
#pragma unroll
    for (int j = 0; j < 2; ++j) { const v4u hw = ((const v4u*)hrow)[64 * j + lane]; const int cc = 8 * (64 * j + lane);
        f32x4 x0, x1; x0[0] = bfl(hw.x); x0[1] = bfh(hw.x); x0[2] = bfl(hw.y); x0[3] = bfh(hw.y); x1[0] = bfl(hw.z); x1[1] = bfh(hw.z); x1[2] = bfl(hw.w); x1[3] = bfh(hw.w);
        const f32x4 g0 = *(const f32x4*)(g + cc), g1 = *(const f32x4*)(g + cc + 4);
        __builtin_nontemporal_store(x0 * rstd * g0, (f32x4*)(orow + cc)); __builtin_nontemporal_store(x1 * rstd * g1, (f32x4*)(orow + cc + 4)); }
}

__device__ __forceinline__ float log2_gamma(float logit) { return log1pf(-expf(logit)) * 1.4426950408889634f; }

__device__ __forceinline__ f32x4 mfma16(bf16x8 a, bf16x8 b, f32x4 c) { return __builtin_amdgcn_mfma_f32_16x16x32_bf16(a, b, c, 0, 0, 0); }

__device__ __forceinline__ void ret_local_states(LAS unsigned char* lds, const bf16_t* RK, const bf16_t* RV, bf16_t* ST, const float* dec_f, const float* dec_b, int G, int bx, int tid) {
    LAS bf16_t* KTF = (LAS bf16_t*)lds; LAS bf16_t* KTB = KTF + 64 * 136; LAS bf16_t* VT = KTB + 64 * 136;
    const int lane = tid & 63, w = tid >> 6, fr = lane & 15, fq = lane >> 4;
    for (int it = bx; it < NRET_ITEMS; it += G) {
        const int ng = it >> 2, h = it & 3, row0 = ng * 128;
        const float lgf = log2_gamma(dec_f[h]), lgb = log2_gamma(dec_b[h]);
        v4u kw[2], vw[4];
#pragma unroll
        for (int r = 0; r < 2; ++r) { const int idx = tid + 512 * r, j = idx & 127, dc = idx >> 7; kw[r] = *(const v4u*)(RK + (size_t)(row0 + j) * 256 + h * 64 + 8 * dc); }
#pragma unroll
        for (int r = 0; r < 4; ++r) { const int idx = tid + 512 * r, j = idx & 127, ec = idx >> 7; vw[r] = *(const v4u*)(RV + (size_t)(row0 + j) * 512 + h * 128 + 8 * ec); }
#pragma unroll
        for (int r = 0; r < 2; ++r) { const int idx = tid + 512 * r, j = idx & 127, dc = idx >> 7;
            const v4u wv = kw[r];
            const float df = __builtin_amdgcn_exp2f((float)(127 - j) * lgf), db = __builtin_amdgcn_exp2f((float)j * lgb);
            float v[8]; v[0] = bfl(wv.x); v[1] = bfh(wv.x); v[2] = bfl(wv.y); v[3] = bfh(wv.y); v[4] = bfl(wv.z); v[5] = bfh(wv.z); v[6] = bfl(wv.w); v[7] = bfh(wv.w);
#pragma unroll
            for (int i = 0; i < 8; ++i) { KTF[(8 * dc + i) * 136 + j] = (bf16_t)f2bf(v[i] * df); KTB[(8 * dc + i) * 136 + j] = (bf16_t)f2bf(v[i] * db); } }
#pragma unroll
        for (int r = 0; r < 4; ++r) { const int idx = tid + 512 * r, j = idx & 127, ec = idx >> 7;
            const v4u wv = vw[r];
            const unsigned ww[4] = {wv.x, wv.y, wv.z, wv.w};
#pragma unroll
            for (int i = 0; i < 4; ++i) { VT[(8 * ec + 2 * i) * 136 + j] = (bf16_t)(ww[i] & 0xffffu); VT[(8 * ec + 2 * i + 1) * 136 + j] = (bf16_t)(ww[i] >> 16); } }
        __syncthreads();
        f32x4 af[4], ab[4];
#pragma unroll
        for (int d = 0; d < 4; ++d) { af[d] = (f32x4){0.f, 0.f, 0.f, 0.f}; ab[d] = af[d]; }
#pragma unroll
        for (int s = 0; s < 4; ++s) {
            const bf16x8 vb = *(const LAS bf16x8*)(VT + (16 * w + fr) * 136 + 32 * s + 8 * fq);
#pragma unroll
            for (int d = 0; d < 4; ++d) {
                const bf16x8 kf = *(const LAS bf16x8*)(KTF + (16 * d + fr) * 136 + 32 * s + 8 * fq);
                const bf16x8 kb = *(const LAS bf16x8*)(KTB + (16 * d + fr) * 136 + 32 * s + 8 * fq);
                af[d] = mfma16(kf, vb, af[d]); ab[d] = mfma16(kb, vb, ab[d]);
            }
        }
        bf16_t* so = ST + (size_t)it * 16384 + (size_t)(16 * w + fr) * 64 + 4 * fq;
#pragma unroll
        for (int d = 0; d < 4; ++d) {
            v2u o; o.x = pk2(af[d][0], af[d][1]); o.y = pk2(af[d][2], af[d][3]); *(v2u*)(so + 16 * d) = o;
            o.x = pk2(ab[d][0], ab[d][1]); o.y = pk2(ab[d][2], ab[d][3]); *(v2u*)(so + 8192 + 16 * d) = o;
        }
        __syncthreads();
    }
}

__device__ __forceinline__ void ret_chain(bf16_t* ST, int cbase, int N, int h, int dir, int v, float cd) {
    float S[8];
#pragma unroll
    for (int e = 0; e < 8; ++e) S[e] = 0.f;
    for (int n0 = 0; n0 < N; n0 += 16) {
        v4u L[16];
#pragma unroll
        for (int k = 0; k < 16; ++k) { const int n = n0 + k, c = dir ? (N - 1 - n) : n; L[k] = *(const v4u*)(ST + ((size_t)((cbase + c) * 4 + h)) * 16384 + dir * 8192 + v * 8); }
        asm volatile("s_waitcnt vmcnt(0)" ::: "memory");
#pragma unroll
        for (int k = 0; k < 16; ++k) { const int n = n0 + k, c = dir ? (N - 1 - n) : n;
            v4u o; o.x = pk2(S[0], S[1]); o.y = pk2(S[2], S[3]); o.z = pk2(S[4], S[5]); o.w = pk2(S[6], S[7]);
            *(v4u*)(ST + ((size_t)((cbase + c) * 4 + h)) * 16384 + dir * 8192 + v * 8) = o;
            S[0] = S[0] * cd + bfl(L[k].x); S[1] = S[1] * cd + bfh(L[k].x); S[2] = S[2] * cd + bfl(L[k].y); S[3] = S[3] * cd + bfh(L[k].y);
            S[4] = S[4] * cd + bfl(L[k].z); S[5] = S[5] * cd + bfh(L[k].z); S[6] = S[6] * cd + bfl(L[k].w); S[7] = S[7] * cd + bfh(L[k].w); }
    }
}
__device__ __forceinline__ void ret_scan(bf16_t* ST, const float* dec_f, const float* dec_b, int G, int bx, int tid) {
    if (tid < 32) {
        for (int task = bx * 32 + tid; task < 8192; task += G * 32) { const int v = task & 1023, dir = (task >> 10) & 1, h = task >> 11;
            const float cd = __builtin_amdgcn_exp2f(128.f * log2_gamma(dir ? dec_b[h] : dec_f[h])); ret_chain(ST, 0, 128, h, dir, v, cd); }
    } else if (tid >= 64 && tid < 320) {
        for (int task = bx * 256 + (tid - 64); task < 65536; task += G * 256) { const int v = task & 1023, dir = (task >> 10) & 1, h = (task >> 11) & 3, sq = task >> 13;
            const float cd = __builtin_amdgcn_exp2f(128.f * log2_gamma(dir ? dec_b[h] : dec_f[h])); ret_chain(ST, 128 + 32 * sq, 32, h, dir, v, cd); }
    }
}

__device__ __forceinline__ void ret_outputs(LAS unsigned char* lds, const bf16_t* RQ, const bf16_t* RK, const bf16_t* RV, bf16_t* RG, const bf16_t* ST, const float* dec_f, const float* dec_b, const float* rnorm, int G, int bx, int tid) {
    LAS bf16_t* QS = (LAS bf16_t*)lds; LAS bf16_t* KS = QS + 128 * 72; LAS bf16_t* VT = KS + 128 * 72; LAS bf16_t* SS = VT + 128 * 136;
    const int lane = tid & 63, w = tid >> 6, fr = lane & 15, fq = lane >> 4;
    for (int it = bx; it < NRET_ITEMS; it += G) {
        const int ng = it >> 2, h = it & 3, row0 = ng * 128;
        const float lgf = log2_gamma(dec_f[h]), lgb = log2_gamma(dec_b[h]);
        v4u qw[2], kw[2], sf[2], sb[2], vw[4];
#pragma unroll
        for (int r = 0; r < 2; ++r) { const int idx = tid + 512 * r, j = idx >> 3, c = idx & 7;
            qw[r] = *(const v4u*)(RQ + (size_t)(row0 + j) * 256 + h * 64 + 8 * c);
            kw[r] = *(const v4u*)(RK + (size_t)(row0 + j) * 256 + h * 64 + 8 * c);
            sf[r] = *(const v4u*)(ST + (size_t)it * 16384 + j * 64 + 8 * c);
            sb[r] = *(const v4u*)(ST + (size_t)it * 16384 + 8192 + j * 64 + 8 * c); }
#pragma unroll
        for (int r = 0; r < 4; ++r) { const int idx = tid + 512 * r, j = idx & 127, ec = idx >> 7; vw[r] = *(const v4u*)(RV + (size_t)(row0 + j) * 512 + h * 128 + 8 * ec); }
#pragma unroll
        for (int r = 0; r < 2; ++r) { const int idx = tid + 512 * r, j = idx >> 3, c = idx & 7;
            *(LAS v4u*)(QS + j * 72 + 8 * c) = qw[r]; *(LAS v4u*)(KS + j * 72 + 8 * c) = kw[r];
            *(LAS v4u*)(SS + j * 72 + 8 * c) = sf[r]; *(LAS v4u*)(SS + 128 * 72 + j * 72 + 8 * c) = sb[r]; }
#pragma unroll
        for (int r = 0; r < 4; ++r) { const int idx = tid + 512 * r, j = idx & 127, ec = idx >> 7;
            const v4u wv = vw[r];
            const unsigned ww[4] = {wv.x, wv.y, wv.z, wv.w};
#pragma unroll
            for (int i = 0; i < 4; ++i) { VT[(8 * ec + 2 * i) * 136 + j] = (bf16_t)(ww[i] & 0xffffu); VT[(8 * ec + 2 * i + 1) * 136 + j] = (bf16_t)(ww[i] >> 16); } }
        __syncthreads();
        const int i0 = 16 * w, il = i0 + fr;
        bf16x8 qf[2];
#pragma unroll
        for (int s = 0; s < 2; ++s) qf[s] = *(const LAS bf16x8*)(QS + il * 72 + 32 * s + 8 * fq);
        f32x4 pt[8];
#pragma unroll
        for (int jb = 0; jb < 8; ++jb) { pt[jb] = (f32x4){0.f, 0.f, 0.f, 0.f};
#pragma unroll
            for (int s = 0; s < 2; ++s) { const bf16x8 kf = *(const LAS bf16x8*)(KS + (16 * jb + fr) * 72 + 32 * s + 8 * fq); pt[jb] = mfma16(kf, qf[s], pt[jb]); }
#pragma unroll
            for (int r = 0; r < 4; ++r) { const int j = 16 * jb + 4 * fq + r, diff = il - j;
                const float f = diff >= 0 ? __builtin_amdgcn_exp2f((float)diff * lgf) : __builtin_amdgcn_exp2f((float)(-diff) * lgb); pt[jb][r] *= f; } }
        bf16x8 pf[4];
#pragma unroll
        for (int s2 = 0; s2 < 4; ++s2) { v4u p; p.x = pk2(pt[2 * s2][0], pt[2 * s2][1]); p.y = pk2(pt[2 * s2][2], pt[2 * s2][3]); p.z = pk2(pt[2 * s2 + 1][0], pt[2 * s2 + 1][1]); p.w = pk2(pt[2 * s2 + 1][2], pt[2 * s2 + 1][3]);
            pf[s2] = __builtin_bit_cast(bf16x8, p); }
        f32x4 o[8];
        const float cf = __builtin_amdgcn_exp2f((float)(il + 1) * lgf), cb = __builtin_amdgcn_exp2f((float)(128 - il) * lgb);
#pragma unroll
        for (int eb = 0; eb < 8; ++eb) { o[eb] = (f32x4){0.f, 0.f, 0.f, 0.f};
#pragma unroll
            for (int s2 = 0; s2 < 4; ++s2) { const s16x4 lo = *(const LAS s16x4*)(VT + (16 * eb + fr) * 136 + 32 * s2 + 4 * fq), hi = *(const LAS s16x4*)(VT + (16 * eb + fr) * 136 + 32 * s2 + 16 + 4 * fq);
                const bf16x8 vf = __builtin_shufflevector(lo, hi, 0, 1, 2, 3, 4, 5, 6, 7); o[eb] = mfma16(vf, pf[s2], o[eb]); }
            f32x4 tf = (f32x4){0.f, 0.f, 0.f, 0.f}, tb = tf;
#pragma unroll
            for (int s = 0; s < 2; ++s) { const bf16x8 sf = *(const LAS bf16x8*)(SS + (16 * eb + fr) * 72 + 32 * s + 8 * fq), sb = *(const LAS bf16x8*)(SS + 128 * 72 + (16 * eb + fr) * 72 + 32 * s + 8 * fq);
                tf = mfma16(sf, qf[s], tf); tb = mfma16(sb, qf[s], tb); }
            o[eb] = o[eb] + tf * cf + tb * cb; }
        float sum = 0.f;
#pragma unroll
        for (int eb = 0; eb < 8; ++eb) sum += (o[eb][0] + o[eb][1]) + (o[eb][2] + o[eb][3]);
        sum += __shfl_xor(sum, 16); sum += __shfl_xor(sum, 32);
        const float mu = sum * (1.0f / 128.0f); float q = 0.f;
#pragma unroll
        for (int eb = 0; eb < 8; ++eb) { const f32x4 d = o[eb] - mu; q += (d[0] * d[0] + d[1] * d[1]) + (d[2] * d[2] + d[3] * d[3]); }
        q += __shfl_xor(q, 16); q += __shfl_xor(q, 32);
        const float rstd = 1.0f / sqrtf(q * (1.0f / 128.0f) + NORM_EPS);
        bf16_t* gp = RG + (size_t)(row0 + il) * 512 + h * 128 + 4 * fq;
#pragma unroll
        for (int eb = 0; eb < 8; ++eb) { const v2u gw = *(const v2u*)(gp + 16 * eb); const f32x4 rn = *(const f32x4*)(rnorm + h * 128 + 16 * eb + 4 * fq);
            const f32x4 y = (o[eb] - mu) * rstd * rn;
            v2u ow; ow.x = pk2(pg8::silu_f(bfl(gw.x)) * y[0], pg8::silu_f(bfh(gw.x)) * y[1]); ow.y = pk2(pg8::silu_f(bfl(gw.y)) * y[2], pg8::silu_f(bfh(gw.y)) * y[3]);
            *(v2u*)(gp + 16 * eb) = ow; }
        __syncthreads();
    }
}

__device__ __forceinline__ bool attn_unit_of(int G, int bx, int i, long& rowbase, int& T, int& h, int& qb) {
    if (G == 256) {
        if (i >= 6) return false;
        const int x = bx & 7, c = bx >> 3;
        if (i < 2) { rowbase = 0; T = PROMPT_ROWS; h = x; qb = 2 * c + i; }
        else { const int u = 4 * c + (i - 2); rowbase = PROMPT_ROWS + (long)x * 4096; T = 4096; h = u >> 4; qb = u & 15; }
        return true;
    }
    const int u = bx + i * G; if (u >= 1536) return false;
    if (u < 512) { rowbase = 0; T = PROMPT_ROWS; h = u >> 6; qb = u & 63; }
    else { const int v = u - 512, sq = v >> 7, w = v & 127; rowbase = PROMPT_ROWS + (long)sq * 4096; T = 4096; h = w >> 4; qb = w & 15; }
    return true;
}

__global__ void __launch_bounds__(NTHREADS, 2) fwd_kernel(Args args) {
    extern __shared__ __attribute__((aligned(16))) unsigned char lds_raw[];
    cg::grid_group grid = cg::this_grid();
    if (threadIdx.x < 64) ((LAS unsigned*)lds_raw)[LDS_MISC / 4 + threadIdx.x] = 0u;
    __syncthreads();
    typedef const __attribute__((address_space(4))) Args* KArgs;
    KArgs ka = (KArgs)__builtin_amdgcn_kernarg_segment_ptr();
#if MULTI_LAUNCH
    const int ph_lo = ka->ph_lo, ph_hi = ka->ph_hi;
#else
    constexpr int ph_lo = 0, ph_hi = NPHASE;
#endif

#ifdef DUP_MASK
    for (int step = 2 * ph_lo; step < 2 * ph_hi; ++step) {
        const int ph = step >> 1; const bool dry = !(step & 1);
        { int dsub = -1; if (ph >= 1 && ph < NPHASE - 1) { const int q = (ph - 1) % 10; dsub = q < 2 ? q + 1 : q < 8 ? q + 2 : q + 3; }
          if (dry && !(dsub >= 0 && ((DUP_MASK >> dsub) & 1))) continue; }
#else
    for (int ph = ph_lo; ph < ph_hi; ++ph) {
        const bool dry = false;
#endif
        asm volatile("" : "+s"(ka) :: "memory");
        const int tid = pg8::opaque_tid(), lane = tid & 63, wave = __builtin_amdgcn_readfirstlane(tid >> 6);
        int G = gridDim.x, bx = blockIdx.x; asm volatile("" : "+s"(G), "+s"(bx));
        const int gw = bx * NWAVES + wave, NGW = G * NWAVES;
        LAS unsigned char* lds = (LAS unsigned char*)lds_raw;
#define AIN(k) ((const float*)ka->in[k])
        unsigned char* const ws = ka->ws;
        float* const X = ka->out;
#define XN ((bf16_t*)(ws + WS_XN))
#define HB ((bf16_t*)(ws + WS_HB))
#define Qb ((bf16_t*)(ws + WS_Q))
#define Kb ((bf16_t*)(ws + WS_K))
#define Vb ((bf16_t*)(ws + WS_V))
#define RQ ((bf16_t*)(ws + WS_RQ))
#define RK ((bf16_t*)(ws + WS_RK))
#define RV ((bf16_t*)(ws + WS_RV))
#define RG ((bf16_t*)(ws + WS_RG))
#define Tb ((bf16_t*)(ws + WS_T))
#define Ub ((bf16_t*)(ws + WS_U))
#define ST ((bf16_t*)(ws + WS_ST))
#define SSF ((float*)(ws + WS_SS))
        const bool is_layer = (ph >= 1 && ph < NPHASE - 1);
        const int l = is_layer ? (ph - 1) / 11 : 0, s11 = is_layer ? (ph - 1) % 11 : -1;
        const int sub = !is_layer ? -1 : (int)((0xCB9D8765421ull >> (4 * s11)) & 15ull);
        bf16_t* const WB = (bf16_t*)(ws + ((l & 1) ? WS_WB1 : WS_WB));
        if (ph == 0) {
            for (int m = gw; m < M_TOK; m += NGW) {
                const f32x4* xr = (const f32x4*)(m < PROMPT_ROWS ? AIN(0) + (size_t)m * DMODEL : AIN(1) + (size_t)(m - PROMPT_ROWS) * DMODEL) + lane;
                v2u* bo = (v2u*)(XN + (size_t)m * DMODEL) + lane;
                float s = 0.f;
#pragma unroll
                for (int j = 0; j < 4; ++j) { const f32x4 v = __builtin_nontemporal_load(xr + 64 * j); v2u w;     w.x = pk2(v.x, v.y); w.y = pk2(v.z, v.w); bo[64 * j] = w; s += (v.x * v.x + v.y * v.y) + (v.z * v.z + v.w * v.w); }
                s = wave_sum(s);
                if (lane < 16) SSF[(size_t)m * 16 + lane] = (lane == 0) ? s : 0.f;
            }
            if (bx == 0) for (int i = tid; i < XCD_BAR_WORDS; i += NTHREADS) ((unsigned*)(ws + WS_BAR))[i] = 0u;
        } else if (ph == NPHASE - 1) {
            for (int m = gw; m < M_TOK; m += NGW) final_row(XN + (size_t)m * DMODEL, SSF + (size_t)m * 16, AIN(20), X + (size_t)m * DMODEL, lane);
        }
        if (sub == 6) ret_scan(ST, AIN(9) + l * 4, AIN(10) + l * 4, G, bx, tid);
        if (ph == 0 || (sub == 6 && l + 1 < DEPTH)) {
            const int cl = (ph == 0) ? 0 : l + 1;
            bf16_t* const WD = (bf16_t*)(ws + ((cl & 1) ? WS_WB1 : WS_WB));
            LAS float* scr = (LAS float*)(lds + wave * 16384);
            constexpr int I0 = 16 * 176, I1 = 44 * 32, I2 = 16 * 72, I3 = 16 * 64, I4 = 8 * 32, I5 = 8 * 32, I6 = 16 * 32, I7 = 16 * 176, I8 = 44 * 32;
            constexpr int NITEMS = I0 + I1 + I2 + I3 + I4 + I5 + I6 + I7 + I8;
            const int cw0 = (ph == 0) ? gw : bx * (NWAVES - 1) + wave - 1, cnw = (ph == 0) ? NGW : G * (NWAVES - 1);
            for (int it = (ph != 0 && wave == 0) ? NITEMS : cw0; it < NITEMS; it += cnw) {
                int r = it;
                if (r < I0) { transpose_item(AIN(3) + (size_t)cl * 1024 * 5632, AIN(2) + cl * 1024, 1024, 5632, WD + OW13A, 1, scr, r, lane); continue; } r -= I0;
                if (r < I1) { transpose_item(AIN(4) + (size_t)cl * 2816 * 1024, nullptr, 2816, 1024, WD + OW2A, 0, scr, r, lane); continue; } r -= I1;
                if (r < I2) { transpose_item(AIN(6) + (size_t)cl * 1024 * 2304, AIN(5) + cl * 1024, 1024, 2304, WD + OWIN, 2, scr, r, lane); continue; } r -= I2;
                if (r < I3) { transpose_item(AIN(14) + (size_t)cl * 1024 * 2048, AIN(5) + cl * 1024, 1024, 2048, WD + OWG, 3, scr, r, lane); continue; } r -= I3;
                if (r < I4) { transpose_item(AIN(12) + (size_t)cl * 512 * 1024, nullptr, 512, 1024, WD + OWBA, 0, scr, r, lane); continue; } r -= I4;
                if (r < I5) { transpose_item(AIN(13) + (size_t)cl * 512 * 1024, nullptr, 512, 1024, WD + OWBR, 0, scr, r, lane); continue; } r -= I5;
                if (r < I6) { transpose_item(AIN(16) + (size_t)cl * 1024 * 1024, nullptr, 1024, 1024, WD + OWO, 0, scr, r, lane); continue; } r -= I6;
                if (r < I7) { transpose_item(AIN(18) + (size_t)cl * 1024 * 5632, AIN(17) + cl * 1024, 1024, 5632, WD + OW13B, 1, scr, r, lane); continue; } r -= I7;
                transpose_item(AIN(19) + (size_t)cl * 2816 * 1024, nullptr, 2816, 1024, WD + OW2B, 0, scr, r, lane);
            }
            asm volatile("s_waitcnt vmcnt(0) lgkmcnt(0)" ::: "memory"); __syncthreads();
        }
        if (is_layer) {
            if (sub == 5) {
                long rowbase; int T, h, qb;
#ifndef NO_ATTN
                for (int i = 0; attn_unit_of(G, bx, i, rowbase, T, h, qb); ++i)
                    attn_body::attn_unit<8>(rowbase, T, h, qb, (const attn_body::bf16*)Qb, (const attn_body::bf16*)Kb, (const attn_body::bf16*)Vb, (attn_body::bf16*)(dry ? Tb : Qb), (char*)lds_raw);
#endif
                __syncthreads();
                ret_local_states(lds, RK, RV, ST, AIN(9) + l * 4, AIN(10) + l * 4, G, bx, tid);
            }
            if (sub == 7) ret_outputs(lds, RQ, RK, RV, RG, ST, AIN(9) + l * 4, AIN(10) + l * 4, AIN(11) + l * 512, G, bx, tid);
            if (sub == 6 || sub == 7) { asm volatile("s_waitcnt vmcnt(0) lgkmcnt(0)" ::: "memory"); __syncthreads(); }
#ifndef NO_G1
            if (sub == 1 || sub == 11) {
                pg8::Gemm g{XN, WB + (sub == 1 ? OW13A : OW13B), M_TOK, 2 * DFF, DMODEL}; pg8::StaticOrder S; S.init(M_TOK, 2 * DFF, G, bx);
                pg8::EpiSwiglu E{HB, DFF, SSF};
                pg8::gemm_phase<pg8::EpiSwiglu, pg8::StaticOrder, true, true>(lds, g, S, E);
            }
#endif
#ifndef NO_G2
            if (sub == 2 || sub == 12 || sub == 9) {
                pg8::Gemm g{sub == 9 ? Tb : HB, WB + (sub == 2 ? OW2A : sub == 12 ? OW2B : OWO), M_TOK, DMODEL, sub == 9 ? DMODEL : DFF}; pg8::StaticOrder S; S.init(M_TOK, DMODEL, G, bx);
                const bool first = (l == 0 && sub == 2);
                pg8::EpiResid E{XN, first ? AIN(0) : (const float*)nullptr, first ? AIN(1) - (size_t)PROMPT_ROWS * DMODEL : (const float*)nullptr, SSF, sub == 9 ? 1.0f : 0.5f};
                pg8::gemm_phase<pg8::EpiResid, pg8::StaticOrder, false, true>(lds, g, S, E);
            }
#endif
#ifndef NO_G3
            if (sub == 4) {
                pg8::Gemm g{XN, WB + OWIN, M_TOK, NPROJ, DMODEL}; pg8::StaticOrder S; S.init(M_TOK, NPROJ, G, bx);
                pg8::EpiInProj E{(bf16_t*)(ws + WS_B), AIN(7) + l * 64, AIN(8) + l * 64, SSF, ATT_C2};
                pg8::gemm_phase<pg8::EpiInProj, pg8::StaticOrder, true, true>(lds, g, S, E);
            }
#endif
#ifndef NO_G4
            if (sub == 6 || sub == 8 || sub == 13) {
                const int mode = (sub == 6) ? 0 : (sub == 8) ? 5 : 4;
                const bf16_t* A = (mode == 0) ? Qb : (mode == 5) ? RG : XN;
                const bf16_t* Bt = WB + ((mode == 0) ? OWBA : (mode == 5) ? OWBR : OWG);
                const int Ng = (mode == 4) ? 2 * DMODEL : DMODEL;
                pg8::Gemm g{A, Bt, M_TOK, Ng, (mode == 4) ? DMODEL : 512}; pg8::StaticOrder S; S.init(M_TOK, Ng, G, bx);
                pg8::EpiMix E{Tb, Ub, AIN(15) + (size_t)l * 2048, SSF, mode};
                pg8::gemm_phase<pg8::EpiMix, pg8::StaticOrder, true, true>(lds, g, S, E);
            }
#endif
        }
#ifdef DUP_MASK
        if (step + 1 < 2 * ph_hi) grid.sync();
#else
        if (ph + 1 < ph_hi) {
            unsigned* const barw = (unsigned*)(ka->ws + WS_BAR);
            if (ph == 0) { grid.sync();
                if (threadIdx.x == 0) (void)xb_add(&barw[XB_XCNT(xb_xcc_id())], 1u); }
            else { XcdBarrier b; b.bar = barw; b.x = xb_xcc_id(); b.st = (volatile LAS unsigned*)((LAS unsigned char*)lds_raw + LDS_MISC + 32); xcd_barrier(b); }
        }
#endif
    }
#ifdef EXTRA_SYNCS
    for (int i = 0; i < EXTRA_SYNCS; ++i) grid.sync();
#endif
}

extern "C" void kernel_launch(void* const* d_in, const int* in_sizes, int n_in, void* d_out, int out_size, void* d_ws, size_t ws_size, hipStream_t stream) {
    static int grid = 0;
    if (grid == 0) {
        if (n_in != 21 || out_size != M_TOK * DMODEL || ws_size < WS_END) { fprintf(stderr, "kernel_launch: unexpected shapes: n_in %d out %d ws %zu (need %zu)\n", n_in, out_size, ws_size, (size_t)WS_END); grid = -1; return; }
        int dev = 0, cus = 0, per_cu = 0;
        if (hipGetDevice(&dev) != hipSuccess || hipDeviceGetAttribute(&cus, hipDeviceAttributeMultiprocessorCount, dev) != hipSuccess) { grid = -1; return; }
        if (hipFuncSetAttribute((const void*)fwd_kernel, hipFuncAttributeMaxDynamicSharedMemorySize, LDS_BYTES) != hipSuccess) { fprintf(stderr, "kernel_launch: hipFuncSetAttribute failed\n"); grid = -1; return; }
        if (hipOccupancyMaxActiveBlocksPerMultiprocessor(&per_cu, (const void*)fwd_kernel, NTHREADS, LDS_BYTES) != hipSuccess || per_cu < 1) { fprintf(stderr, "kernel_launch: occupancy query says %d\n", per_cu); per_cu = 1; }
        (void)hipGetLastError();
        grid = cus * per_cu;
    }
    if (grid < 0) return;
    Args a{};
    for (int i = 0; i < 21; ++i) a.in[i] = (const float*)d_in[i];
    a.out = (float*)d_out; a.ws = (unsigned char*)d_ws;
#if MULTI_LAUNCH
    for (int ph = 0; ph < NPHASE; ++ph) {
        a.ph_lo = ph; a.ph_hi = ph + 1;
        hipLaunchKernelGGL(fwd_kernel, dim3(grid), dim3(NTHREADS), LDS_BYTES, stream, a);
    }
#else
    a.ph_lo = 0; a.ph_hi = NPHASE;
    void* kargs[] = {&a};
    hipError_t e = hipLaunchCooperativeKernel((const void*)fwd_kernel, dim3(grid), dim3(NTHREADS), kargs, LDS_BYTES, stream);
    if (e != hipSuccess) fprintf(stderr, "kernel_launch: cooperative launch failed: %s (grid %d)\n", hipGetErrorString(e), grid);
#endif
}
```
